# Optimizing an MI355X kernel written in HIP

```python
import math
import jax
import jax.numpy as jnp
from jax import lax
import numpy as np

D_MODEL = 1024
BATCH = 2
SEQ = 8192
DEPTH = 2
DEC_BATCH = 128
DEC_SEQ = 4
PAST_LEN = 8192
PAGE_SIZE = 128

N_EVEN = (DEPTH + 1) // 2
N_ODD = DEPTH // 2
NORM_EPS = 1e-6

S5_WIDTH = D_MODEL // 2
S5_GROUP = 16
S5_GROUPS = S5_WIDTH // S5_GROUP
S5_STATE = 64
S5_DT_MIN = 1e-3
S5_DT_MAX = 1e-1

GLA_HEADS = 4
GLA_V_WIDTH = D_MODEL // 2
GLA_K_WIDTH = GLA_V_WIDTH // 2
GLA_HEAD_K = GLA_K_WIDTH // GLA_HEADS
GLA_HEAD_V = GLA_V_WIDTH // GLA_HEADS
GLA_GATE_RANK = 16
GLA_GATE_TAU = 16.0
GLA_CHUNK = 64

EVEN_COLS = (S5_WIDTH, S5_WIDTH, GLA_K_WIDTH, GLA_K_WIDTH, GLA_V_WIDTH, GLA_GATE_RANK, GLA_V_WIDTH)
EVEN_IN = sum(EVEN_COLS)
EVEN_SPLIT = tuple(np.cumsum(EVEN_COLS[:-1]).tolist())
EVEN_MIX = S5_WIDTH + GLA_V_WIDTH

SWA_HEADS = 16
SWA_KV_HEADS = 2
SWA_GROUP = SWA_HEADS // SWA_KV_HEADS
SWA_HEAD_DIM = 64
SWA_WINDOW = 128
ROPE_THETA = 10000.0
SWA_Q_WIDTH = SWA_HEADS * SWA_HEAD_DIM
SWA_KV_WIDTH = SWA_KV_HEADS * SWA_HEAD_DIM
ODD_COLS = (SWA_Q_WIDTH, SWA_KV_WIDTH, SWA_KV_WIDTH, SWA_Q_WIDTH)
ODD_IN = sum(ODD_COLS)
ODD_SPLIT = tuple(np.cumsum(ODD_COLS[:-1]).tolist())

kernel_name = 'hybrid_s5_gla_swa_sink_step'


def rms_norm(x, g):
    xf = x.astype(jnp.float32)
    y = xf * lax.rsqrt(jnp.mean(xf * xf, axis=-1, keepdims=True) + NORM_EPS)
    return (y * g.astype(jnp.float32)).astype(x.dtype)


def s5_discretize(lam_re, lam_im, b_re, b_im, log_dt):
    lam = lax.complex(lam_re.astype(jnp.float32), lam_im.astype(jnp.float32))
    dt = jnp.exp(log_dt.astype(jnp.float32))[:, None]
    lam_bar = jnp.exp(lam * dt)
    b = lax.complex(b_re.astype(jnp.float32), b_im.astype(jnp.float32))
    b_bar = ((lam_bar - 1.0) / lam)[..., None] * b
    return lam_bar, b_bar


def _linear_combine(e1, e2):
    a1, b1 = e1
    a2, b2 = e2
    return a2 * a1, a2 * b1 + b2


def s5_scan(u, state0, lam_bar, b_bar, c_re, c_im, d):
    n, l, _ = u.shape
    ug = u.reshape(n, l, S5_GROUPS, S5_GROUP).astype(jnp.complex64)
    bu = jnp.einsum('gpc,nlgc->nlgp', b_bar, ug)
    bu = bu.at[:, 0].add(lam_bar * state0)
    a = jnp.broadcast_to(lam_bar, bu.shape)
    _, xs = lax.associative_scan(_linear_combine, (a, bu), axis=1)
    c = lax.complex(c_re.astype(jnp.float32), c_im.astype(jnp.float32))
    y = jnp.einsum('gcp,nlgp->nlgc', c, xs).real.reshape(n, l, S5_WIDTH) + d.astype(jnp.float32) * u
    return y, xs[:, -1]


def gla_chunked(q, k, v, log_a, s0):
    n, l = q.shape[:2]
    c = math.gcd(l, GLA_CHUNK)
    nc = l // c

    def to_chunks(t):
        return t.reshape(n, nc, c, GLA_HEADS, t.shape[-1]).transpose(1, 0, 3, 2, 4)

    qc, kc, vc, ac = to_chunks(q), to_chunks(k), to_chunks(v), to_chunks(log_a)
    causal = jnp.tril(jnp.ones((c, c), dtype=bool))

    def step(s, inp):
        qi, ki, vi, ai = inp
        b = jnp.cumsum(ai, axis=-2)
        b_last = b[..., -1:, :]
        q_dec = qi * jnp.exp(b)
        k_dec = ki * jnp.exp(-b)
        att = jnp.where(causal, jnp.einsum('nhik,nhjk->nhij', q_dec, k_dec), 0.0)
        o = jnp.einsum('nhij,nhjv->nhiv', att, vi) + jnp.einsum('nhik,nhkv->nhiv', q_dec, s)
        k_tail = ki * jnp.exp(b_last - b)
        s_new = jnp.exp(b_last[..., 0, :])[..., None] * s + jnp.einsum('nhjk,nhjv->nhkv', k_tail, vi)
        return s_new, o

    s_final, oc = lax.scan(step, s0, (qc, kc, vc, ac))
    o = oc.transpose(1, 0, 3, 2, 4).reshape(n, l, GLA_HEADS, GLA_HEAD_V)
    return o, s_final


def even_layer(x, s5_state0, gla_state0, p):
    n, l, _ = x.shape
    proj = (rms_norm(x, p['norm_g']) @ p['w_in']).astype(jnp.float32)
    u, gate_a, q, k, v, a_low, gate_b = jnp.split(proj, EVEN_SPLIT, axis=-1)
    lam_bar, b_bar = s5_discretize(p['lam_re'], p['lam_im'], p['b_re'], p['b_im'], p['log_dt'])
    y, s5_last = s5_scan(u, s5_state0, lam_bar, b_bar, p['c_re'], p['c_im'], p['d'])
    z = jax.nn.gelu(y)
    z = z * jax.nn.sigmoid(z @ p['w_glu'].astype(jnp.float32) + p['b_glu'].astype(jnp.float32))
    out_a = z * jax.nn.silu(gate_a)
    q = q.reshape(n, l, GLA_HEADS, GLA_HEAD_K) * (GLA_HEAD_K ** -0.5)
    k = k.reshape(n, l, GLA_HEADS, GLA_HEAD_K)
    v = v.reshape(n, l, GLA_HEADS, GLA_HEAD_V)
    gate_logit = a_low @ p['w_gate'].astype(jnp.float32) + p['b_gate'].astype(jnp.float32)
    log_a = (jax.nn.log_sigmoid(gate_logit) / GLA_GATE_TAU).reshape(n, l, GLA_HEADS, GLA_HEAD_K)
    o, gla_last = gla_chunked(q, k, v, log_a, gla_state0)
    out_b = rms_norm(o, p['gla_norm_g']).reshape(n, l, GLA_V_WIDTH) * jax.nn.silu(gate_b)
    mix = jnp.concatenate([out_a, out_b], axis=-1).astype(x.dtype) @ p['w_out']
    return x + mix, s5_last, gla_last


def rope(x, pos):
    half = SWA_HEAD_DIM // 2
    inv_freq = ROPE_THETA ** (-jnp.arange(half, dtype=jnp.float32) / half)
    ang = pos.astype(jnp.float32)[:, None] * inv_freq[None, :]
    cos = jnp.cos(ang)[:, None, :]
    sin = jnp.sin(ang)[:, None, :]
    x = x.astype(jnp.float32)
    x1, x2 = x[..., :half], x[..., half:]
    return jnp.concatenate([x1 * cos - x2 * sin, x2 * cos + x1 * sin], axis=-1)


def sink_attention(q, k, v, q_pos, k_pos, sinks):
    s = jnp.einsum('...qhgd,...khd->...hgqk', q, k) * (SWA_HEAD_DIM ** -0.5)
    diff = q_pos[..., :, None] - k_pos[..., None, :]
    allowed = (diff >= 0) & (diff < SWA_WINDOW) & (k_pos[..., None, :] >= 0)
    s = jnp.where(allowed[..., None, None, :, :], s, -jnp.inf)
    sink = sinks.astype(jnp.float32).reshape(SWA_KV_HEADS, SWA_GROUP, 1, 1)
    m = jnp.maximum(jnp.max(s, axis=-1, keepdims=True), sink)
    pr = jnp.exp(s - m)
    denom = jnp.sum(pr, axis=-1, keepdims=True) + jnp.exp(sink - m)
    return jnp.einsum('...hgqk,...khd->...qhgd', pr / denom, v)


def swa_project(x, pos, p):
    n, l, _ = x.shape
    proj = (rms_norm(x, p['norm_g']) @ p['w_in']).astype(jnp.float32)
    q, k, v, gate = jnp.split(proj, ODD_SPLIT, axis=-1)
    q = rope(rms_norm(q.reshape(n, l, SWA_HEADS, SWA_HEAD_DIM), p['q_norm_g']), pos)
    k = rope(rms_norm(k.reshape(n, l, SWA_KV_HEADS, SWA_HEAD_DIM), p['k_norm_g']), pos)
    v = v.reshape(n, l, SWA_KV_HEADS, SWA_HEAD_DIM)
    return q, k, v, gate


def swa_output(x, o, gate, p):
    n, l, _ = x.shape
    o = o.reshape(n, l, SWA_Q_WIDTH) * jax.nn.silu(gate)
    return x + o.astype(x.dtype) @ p['w_out']


def odd_layer_prompt(x, p):
    n, l, _ = x.shape
    pos = jnp.arange(l, dtype=jnp.int32)
    q, k, v, gate = swa_project(x, pos, p)
    nb = l // SWA_WINDOW
    qb = q.reshape(n, nb, SWA_WINDOW, SWA_KV_HEADS, SWA_GROUP, SWA_HEAD_DIM)

    def band(t):
        tb = t.reshape(n, nb, SWA_WINDOW, SWA_KV_HEADS, SWA_HEAD_DIM)
        prev = jnp.pad(tb, ((0, 0), (1, 0), (0, 0), (0, 0), (0, 0)))[:, :-1]
        return jnp.concatenate([prev, tb], axis=2)

    pos_b = pos.reshape(nb, SWA_WINDOW)
    k_pos = jnp.concatenate([pos_b - SWA_WINDOW, pos_b], axis=1)
    o = sink_attention(qb, band(k), band(v), pos_b, k_pos, p['sinks'])
    cache_len = min(SWA_WINDOW, l)
    return swa_output(x, o, gate, p), k[:, -cache_len:], v[:, -cache_len:]


def odd_layer_sample(x, k_cache, v_cache, p):
    n, l, _ = x.shape
    c = k_cache.shape[1]
    pos = PAST_LEN + jnp.arange(l, dtype=jnp.int32)
    q, k, v, gate = swa_project(x, pos, p)
    kk = jnp.concatenate([k_cache.astype(jnp.float32), k], axis=1)
    vv = jnp.concatenate([v_cache.astype(jnp.float32), v], axis=1)
    k_pos = (PAST_LEN - c) + jnp.arange(c + l, dtype=jnp.int32)
    qg = q.reshape(n, l, SWA_KV_HEADS, SWA_GROUP, SWA_HEAD_DIM)
    o = sink_attention(qg, kk, vv, pos, k_pos, p['sinks'])
    return swa_output(x, o, gate, p), kk[:, -c:], vv[:, -c:]


def setup_inputs(seed: int = 0) -> dict:
    key = jax.random.key(seed)
    ks = iter(jax.random.split(key, 40))

    def nrm(shape, scale):
        return scale * jax.random.normal(next(ks), shape, jnp.float32)

    swa_cache = min(SWA_WINDOW, PAST_LEN)
    lam_re = -0.5 + nrm((N_EVEN, S5_GROUPS, S5_STATE), 0.01)
    lam_im = jnp.pi * jnp.arange(S5_STATE, dtype=jnp.float32) + nrm((N_EVEN, S5_GROUPS, S5_STATE), 0.01)
    log_dt = jax.random.uniform(next(ks), (N_EVEN, S5_GROUPS), jnp.float32,
                                minval=math.log(S5_DT_MIN), maxval=math.log(S5_DT_MAX))
    return {
        'x_prompt': nrm((BATCH, SEQ, D_MODEL), 1.0),
        'x_sample': nrm((DEC_BATCH, DEC_SEQ, D_MODEL), 1.0),
        'state_s5_re': nrm((N_EVEN, DEC_BATCH, S5_GROUPS, S5_STATE), 0.1),
        'state_s5_im': nrm((N_EVEN, DEC_BATCH, S5_GROUPS, S5_STATE), 0.1),
        'state_gla': nrm((N_EVEN, DEC_BATCH, GLA_HEADS, GLA_HEAD_K, GLA_HEAD_V), 0.5),
        'cache_swa_k': nrm((N_ODD, DEC_BATCH, swa_cache, SWA_KV_HEADS, SWA_HEAD_DIM), 1.0),
        'cache_swa_v': nrm((N_ODD, DEC_BATCH, swa_cache, SWA_KV_HEADS, SWA_HEAD_DIM), 1.0),
        'even_norm_g': 1.0 + nrm((N_EVEN, D_MODEL), 0.01),
        'even_w_in': nrm((N_EVEN, D_MODEL, EVEN_IN), D_MODEL ** -0.5),
        's5_lambda_re': lam_re,
        's5_lambda_im': lam_im,
        's5_log_dt': log_dt,
        's5_b_re': nrm((N_EVEN, S5_GROUPS, S5_STATE, S5_GROUP), (2 * S5_GROUP) ** -0.5),
        's5_b_im': nrm((N_EVEN, S5_GROUPS, S5_STATE, S5_GROUP), (2 * S5_GROUP) ** -0.5),
        's5_c_re': nrm((N_EVEN, S5_GROUPS, S5_GROUP, S5_STATE), (2 * S5_STATE) ** -0.5),
        's5_c_im': nrm((N_EVEN, S5_GROUPS, S5_GROUP, S5_STATE), (2 * S5_STATE) ** -0.5),
        's5_d': nrm((N_EVEN, S5_WIDTH), 1.0),
        's5_w_glu': nrm((N_EVEN, S5_WIDTH, S5_WIDTH), S5_WIDTH ** -0.5),
        's5_b_glu': nrm((N_EVEN, S5_WIDTH), 0.01),
        'gla_w_gate': nrm((N_EVEN, GLA_GATE_RANK, GLA_K_WIDTH), GLA_GATE_RANK ** -0.5),
        'gla_b_gate': nrm((N_EVEN, GLA_K_WIDTH), 0.01),
        'gla_norm_g': 1.0 + nrm((N_EVEN, GLA_HEAD_V), 0.01),
        'even_w_out': nrm((N_EVEN, EVEN_MIX, D_MODEL), EVEN_MIX ** -0.5),
        'odd_norm_g': 1.0 + nrm((N_ODD, D_MODEL), 0.01),
        'odd_w_in': nrm((N_ODD, D_MODEL, ODD_IN), D_MODEL ** -0.5),
        'swa_q_norm_g': 1.0 + nrm((N_ODD, SWA_HEAD_DIM), 0.01),
        'swa_k_norm_g': 1.0 + nrm((N_ODD, SWA_HEAD_DIM), 0.01),
        'swa_sinks': nrm((N_ODD, SWA_HEADS), 0.5),
        'odd_w_out': nrm((N_ODD, SWA_Q_WIDTH, D_MODEL), SWA_Q_WIDTH ** -0.5),
    }


def reference(x_prompt, x_sample, state_s5_re, state_s5_im, state_gla, cache_swa_k, cache_swa_v,
              even_norm_g, even_w_in, s5_lambda_re, s5_lambda_im, s5_log_dt, s5_b_re, s5_b_im,
              s5_c_re, s5_c_im, s5_d, s5_w_glu, s5_b_glu, gla_w_gate, gla_b_gate, gla_norm_g,
              even_w_out, odd_norm_g, odd_w_in, swa_q_norm_g, swa_k_norm_g, swa_sinks, odd_w_out):
    hp, hs = x_prompt, x_sample
    s5r_p, s5i_p, gla_p, swk_p, swv_p = [], [], [], [], []
    s5r_s, s5i_s, gla_s, swk_s, swv_s = [], [], [], [], []
    for layer in range(DEPTH):
        i = layer // 2
        if layer % 2 == 0:
            p = {'norm_g': even_norm_g[i], 'w_in': even_w_in[i], 'lam_re': s5_lambda_re[i],
                 'lam_im': s5_lambda_im[i], 'log_dt': s5_log_dt[i], 'b_re': s5_b_re[i], 'b_im': s5_b_im[i],
                 'c_re': s5_c_re[i], 'c_im': s5_c_im[i], 'd': s5_d[i], 'w_glu': s5_w_glu[i],
                 'b_glu': s5_b_glu[i], 'w_gate': gla_w_gate[i], 'b_gate': gla_b_gate[i],
                 'gla_norm_g': gla_norm_g[i], 'w_out': even_w_out[i]}
            nb = hp.shape[0]
            s5_zero = jnp.zeros((nb, S5_GROUPS, S5_STATE), jnp.complex64)
            gla_zero = jnp.zeros((nb, GLA_HEADS, GLA_HEAD_K, GLA_HEAD_V), jnp.float32)
            hp, s5_last_p, gla_last_p = even_layer(hp, s5_zero, gla_zero, p)
            s5_init = lax.complex(state_s5_re[i].astype(jnp.float32), state_s5_im[i].astype(jnp.float32))
            hs, s5_last_s, gla_last_s = even_layer(hs, s5_init, state_gla[i].astype(jnp.float32), p)
            s5r_p.append(s5_last_p.real)
            s5i_p.append(s5_last_p.imag)
            gla_p.append(gla_last_p)
            s5r_s.append(s5_last_s.real)
            s5i_s.append(s5_last_s.imag)
            gla_s.append(gla_last_s)
        else:
            p = {'norm_g': odd_norm_g[i], 'w_in': odd_w_in[i], 'q_norm_g': swa_q_norm_g[i],
                 'k_norm_g': swa_k_norm_g[i], 'sinks': swa_sinks[i], 'w_out': odd_w_out[i]}
            hp, k_p, v_p = odd_layer_prompt(hp, p)
            hs, k_s, v_s = odd_layer_sample(hs, cache_swa_k[i], cache_swa_v[i], p)
            swk_p.append(k_p)
            swv_p.append(v_p)
            swk_s.append(k_s)
            swv_s.append(v_s)
    return (hp, hs,
            jnp.stack(s5r_p), jnp.stack(s5i_p), jnp.stack(gla_p), jnp.stack(swk_p), jnp.stack(swv_p),
            jnp.stack(s5r_s), jnp.stack(s5i_s), jnp.stack(gla_s), jnp.stack(swk_s), jnp.stack(swv_s))
```

```cpp
#include <hip/hip_runtime.h>
#include <hip/hip_cooperative_groups.h>
#include <cstdio>
#include <cstdint>
namespace cg = cooperative_groups;
namespace pg8 {
#define PG8_LAS __attribute__((address_space(3)))
typedef unsigned short bf16_t;
typedef short bf16x8 __attribute__((ext_vector_type(8)));
typedef float f32x4 __attribute__((ext_vector_type(4)));
typedef unsigned u32x4 __attribute__((ext_vector_type(4)));
constexpr int BM = 256, BK = 64, HALF = 128, HTB = HALF * BK * 2  , STAGE_BYTES = 8 * HTB, NXCD = 8, WGM = 8;

__host__ __device__ __forceinline__ int lds_byte(int r, int c) { const int st = (r >> 4) * 2 + (c >> 5), rr = r & 15, cc = c & 31, ob = rr * 64 + cc * 2; return st * 1024 + (ob ^ (((ob >> 9) & 1) << 5)); }
__host__ __device__ __forceinline__ void stage_rc(int b, int& R, int& C) { const int st = b / 1024, sb = b % 1024, swz = sb ^ (((sb >> 9) & 1) << 5); R = (st >> 1) * 16 + swz / 64; C = (st & 1) * 32 + (swz % 64) / 2; }
__host__ __device__ __forceinline__ int perm32(int rho) { const int n = rho >> 4, i = rho & 15; return 8 * (i >> 2) + 4 * n + (i & 3); }

struct Unit { int pm, pn; };
struct Gemm { const bf16_t* A; const bf16_t* Bt; int M, N, K; };

struct StaticOrder {
    int nM, nN, nwg, G, c;
    __host__ __device__ void init(int M, int N, int G_, int c_) { nM = M / BM; nN = N / BM; nwg = nM * nN; G = G_; c = c_; }
    __host__ __device__ bool next(int i, Unit& u) const {
        const long L = (long)i * G + c; if (L >= nwg) return false;
        int wgid = (int)L; { const int q = nwg / NXCD, r = nwg % NXCD, xcd = wgid % NXCD, off = wgid / NXCD; wgid = (xcd < r ? xcd * (q + 1) : r * (q + 1) + (xcd - r) * q) + off; }
        const int nig = WGM * nN, gid = wgid / nig, fm = gid * WGM, gsz = (nM - fm) < WGM ? (nM - fm) : WGM;
        u.pm = fm + ((wgid % nig) % gsz); u.pn = (wgid % nig) / gsz; return true;
    }
    __device__ __forceinline__ void a_ready(const Unit&) const {}
    __device__ __forceinline__ void done(const Unit&) const {}
};
__device__ __forceinline__ unsigned cvt_pk_bf16(float lo, float hi) { unsigned r; asm volatile("v_cvt_pk_bf16_f32 %0, %1, %2" : "=v"(r) : "v"(lo), "v"(hi)); return r; }
template <class Epi, class Sched, bool ALIGN_EPI = false, bool SP2 = false>
__device__ __forceinline__ void gemm_phase(PG8_LAS unsigned char* lds, const Gemm g, const Sched& S, const Epi& E) {
    const int tid = threadIdx.x, wid = __builtin_amdgcn_readfirstlane(tid >> 6), lane = tid & 63, wr = wid >> 2, wc = wid & 3, fr = lane & 15, fq = lane >> 4;
    const int K = g.K, nt = K / BK;
    unsigned voffA[2], voffB[2];
#pragma unroll
    for (int i = 0; i < 2; ++i) { int R, C; stage_rc(tid * 16 + i * 8192, R, C); const int Rb = Epi::PERM ? ((R & ~31) + perm32(R & 31)) : R;
        voffA[i] = (unsigned)(R * K + C) * 2u; voffB[i] = (unsigned)(Rb * K + C) * 2u; }
    const size_t kstep = (size_t)(BK * 2);
    const size_t hstep = (size_t)HALF * K * 2;
    const size_t tstep = 2 * hstep;
    const unsigned ldsw = (unsigned)wid * 1024u;
    const int aoff = lds_byte(wr * 64 + fr, fq * 8), boff = lds_byte(wc * 32 + fr, fq * 8);
#define PG8_SA(b, h) (((b) * 2 + (h)) * HTB)
#define PG8_SB(b, h) ((4 + (b) * 2 + (h)) * HTB)
#define PG8_STAGE(bufoff, gbase, voff) do { _Pragma("unroll") for (int _i = 0; _i < 2; ++_i) \
        __builtin_amdgcn_global_load_lds((const unsigned*)((const char*)(gbase) + (voff)[_i]), (PG8_LAS unsigned*)(lds + (bufoff) + ldsw + _i * 8192), 16, 0, 0); } while (0)
#define PG8_LDA(dst, b, h) do { _Pragma("unroll") for (int m = 0; m < 4; ++m) _Pragma("unroll") for (int k = 0; k < 2; ++k) dst[m][k] = *(const PG8_LAS bf16x8*)(lds + PG8_SA(b, h) + aoff + m * 2048 + k * 1024); } while (0)
#define PG8_LDB(dst, b, h) do { _Pragma("unroll") for (int n = 0; n < 2; ++n) _Pragma("unroll") for (int k = 0; k < 2; ++k) dst[n][k] = *(const PG8_LAS bf16x8*)(lds + PG8_SB(b, h) + boff + n * 2048 + k * 1024); } while (0)
#define PG8_MMA(ai, bj, At, Bt) do { __builtin_amdgcn_s_setprio(1); _Pragma("unroll") for (int m = 0; m < 4; ++m) _Pragma("unroll") for (int n = 0; n < 2; ++n) _Pragma("unroll") for (int k = 0; k < 2; ++k) \
        acc[ai][bj][m][n] = __builtin_amdgcn_mfma_f32_16x16x32_bf16(Bt[n][k], At[m][k], acc[ai][bj][m][n], 0, 0, 0); __builtin_amdgcn_s_setprio(0); } while (0)
#define PG8_WAIT_V(n) asm volatile("s_waitcnt vmcnt(" #n ")" ::: "memory")
#define PG8_WAIT_L(n) asm volatile("s_waitcnt lgkmcnt(" #n ")" ::: "memory")
#define PG8_BAR __builtin_amdgcn_s_barrier()
#define PG8_SCHED __builtin_amdgcn_sched_barrier(0)
    Unit cur, nxt; int ui = 0;
    if (!S.next(0, cur)) return;
    f32x4 acc[2][2][4][2];
#pragma unroll
    for (int a = 0; a < 2; ++a)
#pragma unroll
        for (int b = 0; b < 2; ++b)
#pragma unroll
            for (int m = 0; m < 4; ++m)
#pragma unroll
                for (int n = 0; n < 2; ++n) acc[a][b][m][n] = (f32x4){0.f, 0.f, 0.f, 0.f};
    bf16x8 At[4][2], B0[2][2], B1[2][2];
    const char* cA = (const char*)g.A + (size_t)cur.pm * tstep; const char* cB = (const char*)g.Bt + (size_t)cur.pn * tstep;
    S.a_ready(cur);
    if constexpr (SP2) {
        PG8_STAGE(PG8_SB(0, 0), cB, voffB); PG8_STAGE(PG8_SB(0, 1), cB + hstep, voffB); PG8_STAGE(PG8_SA(0, 0), cA, voffA); PG8_STAGE(PG8_SA(0, 1), cA + hstep, voffA);
        if (wr == 1) PG8_BAR;
        PG8_WAIT_V(2); PG8_BAR;
        PG8_STAGE(PG8_SB(1, 0), cB + kstep, voffB); PG8_STAGE(PG8_SA(1, 0), cA + kstep, voffA); PG8_STAGE(PG8_SB(1, 1), cB + hstep + kstep, voffB);
        PG8_WAIT_V(6); PG8_BAR;
    } else {
        PG8_STAGE(PG8_SB(0, 0), cB, voffB); PG8_STAGE(PG8_SA(0, 0), cA, voffA); PG8_STAGE(PG8_SB(0, 1), cB + hstep, voffB); PG8_STAGE(PG8_SA(0, 1), cA + hstep, voffA);
        if (wr == 1) PG8_BAR;
        PG8_WAIT_V(4); PG8_BAR;
        PG8_STAGE(PG8_SB(1, 0), cB + kstep, voffB); PG8_STAGE(PG8_SA(1, 0), cA + kstep, voffA); PG8_STAGE(PG8_SB(1, 1), cB + hstep + kstep, voffB);
        PG8_WAIT_V(6); PG8_BAR;
    }
    for (;;) {
        const bool has_next = S.next(ui + 1, nxt);
        const char* nA = has_next ? (const char*)g.A + (size_t)nxt.pm * tstep : cA; const char* nB = has_next ? (const char*)g.Bt + (size_t)nxt.pn * tstep : cB;
        for (int t = 0; t < nt; t += 2) {
            const bool last = (t == nt - 2);
            const char* a1 = cA + (size_t)(t + 1) * kstep;
            const char* a2 = last ? nA : cA + (size_t)(t + 2) * kstep; const char* b2 = last ? nB : cB + (size_t)(t + 2) * kstep;
            const char* a3 = a2 + kstep; const char* b3 = b2 + kstep;
            if (last && has_next) S.a_ready(nxt);
            if constexpr (SP2) {
            PG8_LDB(B0, 0, 0); PG8_LDB(B1, 0, 1); PG8_SCHED; PG8_LDA(At, 0, 0); PG8_STAGE(PG8_SA(1, 1), a1 + hstep, voffA);
            PG8_WAIT_V(8); PG8_WAIT_L(0); PG8_BAR; PG8_MMA(0, 0, At, B0); PG8_MMA(0, 1, At, B1); PG8_BAR; PG8_SCHED;
            PG8_LDA(At, 0, 1); PG8_STAGE(PG8_SB(0, 0), b2, voffB); PG8_STAGE(PG8_SB(0, 1), b2 + hstep, voffB); PG8_STAGE(PG8_SA(0, 0), a2, voffA);
            PG8_WAIT_V(8); PG8_WAIT_L(0); PG8_BAR; PG8_MMA(1, 0, At, B0); PG8_MMA(1, 1, At, B1); PG8_BAR; PG8_SCHED;
            PG8_LDB(B0, 1, 0); PG8_LDB(B1, 1, 1); PG8_SCHED; PG8_LDA(At, 1, 0); PG8_STAGE(PG8_SA(0, 1), a2 + hstep, voffA);
            PG8_WAIT_V(8); PG8_WAIT_L(0); PG8_BAR; PG8_MMA(0, 0, At, B0); PG8_MMA(0, 1, At, B1); PG8_BAR; PG8_SCHED;
            PG8_LDA(At, 1, 1); PG8_STAGE(PG8_SB(1, 0), b3, voffB); PG8_STAGE(PG8_SB(1, 1), b3 + hstep, voffB); PG8_STAGE(PG8_SA(1, 0), a3, voffA);
            PG8_WAIT_V(8); PG8_WAIT_L(0); PG8_BAR; PG8_MMA(1, 0, At, B0); PG8_MMA(1, 1, At, B1); PG8_BAR; PG8_SCHED;
            } else {
            PG8_LDB(B0, 0, 0); PG8_SCHED; PG8_LDA(At, 0, 0); PG8_STAGE(PG8_SA(1, 1), a1 + hstep, voffA);
            PG8_WAIT_L(8); PG8_BAR; PG8_WAIT_L(0); PG8_MMA(0, 0, At, B0); PG8_BAR; PG8_SCHED;
            PG8_LDB(B1, 0, 1); PG8_STAGE(PG8_SB(0, 0), b2, voffB);
            PG8_BAR; PG8_WAIT_L(0); PG8_MMA(0, 1, At, B1); PG8_BAR;
            PG8_LDA(At, 0, 1); PG8_STAGE(PG8_SA(0, 0), a2, voffA);
            PG8_BAR; PG8_WAIT_L(0); PG8_MMA(1, 0, At, B0); PG8_BAR; PG8_SCHED;
            PG8_STAGE(PG8_SB(0, 1), b2 + hstep, voffB);
            PG8_WAIT_V(6); PG8_BAR; PG8_MMA(1, 1, At, B1); PG8_BAR;
            PG8_LDB(B0, 1, 0); PG8_SCHED; PG8_LDA(At, 1, 0); PG8_STAGE(PG8_SA(0, 1), a2 + hstep, voffA);
            PG8_WAIT_L(8); PG8_BAR; PG8_WAIT_L(0); PG8_MMA(0, 0, At, B0); PG8_BAR; PG8_SCHED;
            PG8_LDB(B1, 1, 1); PG8_STAGE(PG8_SB(1, 0), b3, voffB);
            PG8_BAR; PG8_WAIT_L(0); PG8_MMA(0, 1, At, B1); PG8_BAR;
            PG8_LDA(At, 1, 1); PG8_STAGE(PG8_SA(1, 0), a3, voffA);
            PG8_BAR; PG8_WAIT_L(0); PG8_MMA(1, 0, At, B0); PG8_BAR; PG8_SCHED;
            PG8_STAGE(PG8_SB(1, 1), b3 + hstep, voffB);
            PG8_WAIT_V(6); PG8_BAR; PG8_MMA(1, 1, At, B1); PG8_BAR;
            }
        }
        if constexpr (ALIGN_EPI) { if (wr == 0) PG8_BAR; }
        if constexpr (!Epi::AFTER_DRAIN) { E(acc, cur, wr, wc, fr, fq); S.done(cur); }
        if (!has_next) break;
#pragma unroll
        for (int a = 0; a < 2; ++a)
#pragma unroll
            for (int b = 0; b < 2; ++b)
#pragma unroll
                for (int m = 0; m < 4; ++m)
#pragma unroll
                    for (int n = 0; n < 2; ++n) acc[a][b][m][n] = (f32x4){0.f, 0.f, 0.f, 0.f};
        cur = nxt; cA = nA; cB = nB; ++ui;
        if constexpr (ALIGN_EPI) { if (wr == 1) PG8_BAR; }
    }
    PG8_WAIT_V(0);
    if constexpr (!ALIGN_EPI) { if (wr == 0) PG8_BAR; }
    PG8_BAR;
    if constexpr (Epi::AFTER_DRAIN) { E.fused(acc, cur, wr, wc, fr, fq, lds, wid, lane); S.done(cur); }
#undef PG8_SA
#undef PG8_SB
#undef PG8_STAGE
#undef PG8_LDA
#undef PG8_LDB
#undef PG8_MMA
#undef PG8_WAIT_V
#undef PG8_WAIT_L
#undef PG8_BAR
#undef PG8_SCHED
}
}

#define LAS __attribute__((address_space(3)))
typedef unsigned short bf16;
typedef unsigned v4u __attribute__((ext_vector_type(4)));
typedef float f32x4 __attribute__((ext_vector_type(4)));
typedef short bf16x8 __attribute__((ext_vector_type(8)));
__device__ __forceinline__ f32x4 mfma16k(const bf16x8 a, const bf16x8 b, const f32x4 c) { const f32x4 d = __builtin_amdgcn_mfma_f32_16x16x32_bf16(a, b, c, 0, 0, 0); asm volatile("" :: "v"(a), "v"(b)); return d; }
#define MFMA16(a, b, c) mfma16k(a, b, c)
#define LDS_WAIT() asm volatile("s_waitcnt lgkmcnt(0)" ::: "memory")
__device__ __forceinline__ f32x4 zacc() { f32x4 z = {0.f, 0.f, 0.f, 0.f}; asm volatile("" : "+v"(z)); return z; }

constexpr int MP = 16384, MS = 512, MT = MP + MS;
constexpr int LDP = 2560;
constexpr size_t MiB = 1u << 20;
constexpr size_t WS_W1T = 0, WS_WGT = 6 * MiB, WS_W3T = 7 * MiB, WS_W4T = 9 * MiB, WS_W6T = 14 * MiB;
constexpr size_t WS_ROPE = 16 * MiB, WS_TAB = 19 * MiB, WS_ALOW = 20 * MiB, WS_LOC = 22 * MiB;
constexpr size_t WS_XN = 26 * MiB;
constexpr size_t WS_Z = WS_XN, WS_QD = WS_XN + 16 * MiB + 512 * 1024, WS_KDEC = WS_QD + 8 * MiB + 256 * 1024;
constexpr size_t WS_PROJ = 59 * MiB;
constexpr size_t WS_UT = 142 * MiB, WS_ST = 190 * MiB, WS_MIX = 214 * MiB, WS_XIN = 248 * MiB, WS_BAR = 252 * MiB, WS_END = 253 * MiB;
constexpr size_t WS_Q = 142 * MiB, WS_GATE = 175 * MiB, WS_KV = 208 * MiB, WS_VTG = 217 * MiB;
constexpr size_t TAB_LAMB = 0, TAB_LAMT = 16384, TAB_BB = 32768, TAB_CMT = 32768 + 262144, TAB_GD = TAB_CMT + 131072, TAB_BBF = 234 * MiB, TAB_SS = 851968;
constexpr int OFF_YS = 16777216, OFF_S5RE_P = 17301504, OFF_S5IM_P = 17305600, OFF_GLA_P = 17309696, OFF_SWK_P = 17375232, OFF_SWV_P = 17408000,
              OFF_S5RE_S = 17440768, OFF_S5IM_S = 17702912, OFF_GLA_S = 17965056, OFF_SWK_S = 22159360, OFF_SWV_S = 24256512, OUT_TOTAL = 26353664;
constexpr int LDS_BYTES = 147456;
constexpr float EPS = 1e-6f;

#ifndef REP_MASK
#define REP_MASK 0
#endif
#ifndef EXTRA_SYNCS
#define EXTRA_SYNCS 0
#endif
struct Params { const float* in[29]; float* out; unsigned char* ws; };
constexpr int PTAB_OFF = LDS_BYTES - 512;
__device__ __forceinline__ LAS unsigned char* lds0() { extern __shared__ __attribute__((aligned(16))) unsigned char lds_dyn_[]; return (LAS unsigned char*)lds_dyn_; }
__device__ __forceinline__ const float* inp_ptr(int k) { const unsigned long long v = ((const LAS unsigned long long*)(lds0() + PTAB_OFF))[k];
    const unsigned lo = __builtin_amdgcn_readfirstlane((unsigned)v), hi = __builtin_amdgcn_readfirstlane((unsigned)(v >> 32)); return (const float*)(((unsigned long long)hi << 32) | lo); }
#define INP(k) inp_ptr(k)

__device__ __forceinline__ float bf2f(unsigned u) { return __builtin_bit_cast(float, u << 16); }
__device__ __forceinline__ unsigned f2bf(float f) { unsigned u = __builtin_bit_cast(unsigned, f); return (u + 0x7fffu + ((u >> 16) & 1u)) >> 16; }
typedef __bf16 bf16x2_t __attribute__((ext_vector_type(2)));
typedef float f32x2_t __attribute__((ext_vector_type(2)));
__device__ __forceinline__ unsigned pk2(float lo, float hi) { return f2bf(lo) | (f2bf(hi) << 16); }
__device__ __forceinline__ float wave_sum(float v) {
#pragma unroll
    for (int o = 1; o < 64; o <<= 1) v += __shfl_xor(v, o);
    return v;
}
__device__ __forceinline__ float wave_max(float v) {
#pragma unroll
    for (int o = 1; o < 64; o <<= 1) v = fmaxf(v, __shfl_xor(v, o));
    return v;
}
__device__ __forceinline__ float sigm(float x) { return __builtin_amdgcn_rcpf(1.f + __expf(-x)); }
__device__ __forceinline__ float silu(float x) { return x * sigm(x); }
__device__ __forceinline__ float gelu_tanh(float y) { const float a = 0.7978845608028654f * (y + 0.044715f * y * y * y); const float th = 1.f - 2.f * __builtin_amdgcn_rcpf(__expf(2.f * a) + 1.f); return 0.5f * y * (1.f + th); }
#define UNPACK8(W_, F_) do { F_[0] = bf2f((W_).x & 0xffffu); F_[1] = bf2f((W_).x >> 16); F_[2] = bf2f((W_).y & 0xffffu); F_[3] = bf2f((W_).y >> 16); \
                           F_[4] = bf2f((W_).z & 0xffffu); F_[5] = bf2f((W_).z >> 16); F_[6] = bf2f((W_).w & 0xffffu); F_[7] = bf2f((W_).w >> 16); } while (0)
#define PACK8(F_) ((v4u){pk2(F_[0], F_[1]), pk2(F_[2], F_[3]), pk2(F_[4], F_[5]), pk2(F_[6], F_[7])})

__device__ __forceinline__ void dsincos(double a, double& s, double& c) {
    const double t = a * 0.15915494309189535; const double q = rint(t * 4.0); const double r = (t - q * 0.25) * 6.283185307179586; const double r2 = r * r;
    const double sp = r * (1.0 + r2 * (-1.0 / 6 + r2 * (1.0 / 120 + r2 * (-1.0 / 5040 + r2 * (1.0 / 362880 + r2 * (-1.0 / 39916800 + r2 * (1.0 / 6227020800.0)))))));
    const double cp = 1.0 + r2 * (-0.5 + r2 * (1.0 / 24 + r2 * (-1.0 / 720 + r2 * (1.0 / 40320 + r2 * (-1.0 / 3628800 + r2 * (1.0 / 479001600 + r2 * (-1.0 / 87178291200.0)))))));
    const int qi = ((int)q) & 3;
    s = (qi == 0) ? sp : (qi == 1) ? cp : (qi == 2) ? -sp : -cp;
    c = (qi == 0) ? cp : (qi == 1) ? -sp : (qi == 2) ? -cp : sp;
}

#define RLX_AGENT __ATOMIC_RELAXED, __HIP_MEMORY_SCOPE_AGENT
#define XB_TMO      128
#define XB_XCNT(j)  (256  + 64 * (j))
#define XB_XSUB(j)  (1280 + 64 * (j))
#define XB_XGEN(j)  (2304 + 64 * (j))
#define XB_TOP      3328
#define XB_TOPGEN   3392
#define XCD_BAR_WORDS 3456
#define XB_SPIN_CAP (1u << 18)

__device__ __forceinline__ unsigned xb_ld(unsigned* p)              { return __hip_atomic_load(p, __ATOMIC_RELAXED, __HIP_MEMORY_SCOPE_AGENT); }
__device__ __forceinline__ unsigned xb_add(unsigned* p, unsigned v) { return __hip_atomic_fetch_add(p, v, __ATOMIC_RELAXED, __HIP_MEMORY_SCOPE_AGENT); }
__device__ __forceinline__ unsigned xb_xcc_id() { return (unsigned)__builtin_amdgcn_s_getreg((3 << 11) | 20) & 0xFu; }
#define XB_SPIN(cond, bar) do { unsigned _sp = 0; while (cond) { __builtin_amdgcn_s_sleep(1); \
    if ((++_sp & 255u) == 0u) { if (xb_ld(&(bar)[XB_TMO])) break; if (_sp > XB_SPIN_CAP) { atomicAdd(&(bar)[XB_TMO], 1u); break; } } } } while (0)

struct XcdBarrier {
    unsigned* bar; unsigned x;
    volatile LAS unsigned* st;
};

__device__ __forceinline__ XcdBarrier xcd_barrier_post(unsigned* bar, volatile LAS unsigned* st) {
    XcdBarrier b; b.bar = bar; b.x = xb_xcc_id(); b.st = st;
    if (threadIdx.x == 0) (void)xb_add(&bar[XB_XCNT(b.x)], 1u);
    return b;
}
__device__ __forceinline__ void xcd_barrier_complete(unsigned* bar, unsigned x, unsigned& nloc, unsigned& nx) {
    const unsigned G = gridDim.x * gridDim.y * gridDim.z;
    unsigned sum, cnt, mine, sp = 0u;
    for (;;) {
        sum = 0u; cnt = 0u; mine = 0u;
#pragma unroll
        for (unsigned j = 0; j < 16; ++j) { const unsigned c = xb_ld(&bar[XB_XCNT(j)]); sum += c; cnt += (c > 0u) ? 1u : 0u; mine = (j == x) ? c : mine; }
        if (sum == G) break;
        __builtin_amdgcn_s_sleep(1);
        if ((++sp & 255u) == 0u) { if (xb_ld(&bar[XB_TMO])) break; if (sp > XB_SPIN_CAP) { atomicAdd(&bar[XB_TMO], 1u); break; } }
    }
    nloc = mine > 0u ? mine : 1u; nx = cnt > 0u ? cnt : 1u;
}

__device__ __forceinline__ void xcd_barrier(const XcdBarrier& b) {
    asm volatile("s_waitcnt vmcnt(0)" ::: "memory");
    __syncthreads();
    if (threadIdx.x == 0) {
        unsigned* bar = b.bar;
        __builtin_amdgcn_s_waitcnt(0);
        unsigned nloc = b.st[0], nx = b.st[1];
        if (nloc == 0u) { xcd_barrier_complete(bar, b.x, nloc, nx); b.st[0] = nloc; b.st[1] = nx; }
        const unsigned old = xb_add(&bar[XB_XSUB(b.x)], 1u);
        const unsigned gen = old / nloc;
        if (old + 1u == (gen + 1u) * nloc) {
            __builtin_amdgcn_fence(__ATOMIC_RELEASE, "agent");
            asm volatile("s_waitcnt vmcnt(0)" ::: "memory");
            const unsigned og = xb_add(&bar[XB_TOP], 1u);
            const unsigned tg = og / nx;
            if (og + 1u == (tg + 1u) * nx) xb_add(&bar[XB_TOPGEN], 1u);
            else XB_SPIN(xb_ld(&bar[XB_TOPGEN]) == tg, bar);
            __builtin_amdgcn_fence(__ATOMIC_ACQUIRE, "agent");
            xb_add(&bar[XB_XGEN(b.x)], 1u);
            asm volatile("s_waitcnt vmcnt(0)" ::: "memory");
        } else {
            XB_SPIN(xb_ld(&bar[XB_XGEN(b.x)]) == gen, bar);
            __builtin_amdgcn_fence(__ATOMIC_ACQUIRE, "agent");
            asm volatile("s_waitcnt vmcnt(0)" ::: "memory");
        }
    }
    __syncthreads();
}

__device__ __forceinline__ int map_w1(int p) { return p < 2048 ? p : (p < 2560 ? p + 16 : (p < 2576 ? p - 512 : -1)); }
__device__ __forceinline__ int map_w4(int p) { if (p >= 1280) return p; const int pn = p >> 8, pp = p & 255; return (4 * pn + ((pp >> 5) & 3)) * 64 + 32 * (pp >> 7) + (pp & 31); }
template <int MODE> __device__ __forceinline__ void transpose_item(const float* W, int K, int N, int NP, bf16* WT, LAS float* scr, int item, int lane) {
    const int nblk = NP / 32, kb = item / nblk, nb = item % nblk, k0 = 64 * kb, n0 = 32 * nb;
    const int p = n0 + (lane & 31);
    const int src = MODE == 0 ? p : (MODE == 1 ? map_w1(p) : map_w4(p));
#pragma unroll 8
    for (int i = 0; i < 32; ++i) { const int kk = 2 * i + (lane >> 5); scr[kk * 33 + (lane & 31)] = src >= 0 ? W[(size_t)(k0 + kk) * N + src] : 0.f; }
    LDS_WAIT();
    const int c = lane & 7;
#pragma unroll
    for (int j = 0; j < 4; ++j) { const int n = (lane >> 3) + 8 * j; const LAS float* s = scr + (8 * c) * 33 + n;
        v4u o; o.x = pk2(s[0 * 33], s[1 * 33]); o.y = pk2(s[2 * 33], s[3 * 33]); o.z = pk2(s[4 * 33], s[5 * 33]); o.w = pk2(s[6 * 33], s[7 * 33]);
        *(v4u*)(WT + (size_t)(n0 + n) * K + k0 + 8 * c) = o; }
    LDS_WAIT();
}
__device__ __forceinline__ void rms_row(const float* xrow, const float* g, bf16* orow, int lane) {
    const f32x4* xr = (const f32x4*)xrow + lane; const f32x4* gr = (const f32x4*)g + lane;
    f32x4 v[4]; float s = 0.f;
#pragma unroll
    for (int j = 0; j < 4; ++j) { v[j] = xr[64 * j]; s += (v[j].x * v[j].x + v[j].y * v[j].y) + (v[j].z * v[j].z + v[j].w * v[j].w); }
    const float r = 1.f / sqrtf(wave_sum(s) * (1.f / 1024.f) + EPS);
    unsigned long long* o8 = (unsigned long long*)orow + lane;
#pragma unroll
    for (int j = 0; j < 4; ++j) { const f32x4 gg = gr[64 * j];
        o8[64 * j] = (unsigned long long)pk2(v[j].x * r * gg.x, v[j].y * r * gg.y) | ((unsigned long long)pk2(v[j].z * r * gg.z, v[j].w * r * gg.w) << 32); }
}

template <int PART> __device__ __forceinline__ void phase0(const Params& P, LAS unsigned char* lds, int tid, int lane, int wave, int wb0) {
    const int G = (int)gridDim.x - wb0, gw = ((int)blockIdx.x - wb0) * 8 + wave, NGW = G * 8;
    unsigned char* ws = P.ws;
    LAS float* scr = (LAS float*)(lds + wave * 16384);
    constexpr int I1 = 16 * 88, IG = 8 * 16, I3 = 16 * 32, I4 = 16 * 72, I6 = 16 * 32;
    if (PART == 0) {
        for (int it = gw; it < I1 + IG; it += NGW) {
            if (it < I1) transpose_item<1>(INP(8), 1024, 2576, 2816, (bf16*)(ws + WS_W1T), scr, it, lane);
            else transpose_item<0>(INP(17), 512, 512, 512, (bf16*)(ws + WS_WGT), scr, it - I1, lane);
        }
    } else {
        for (int it = gw; it < I3 + I4 + I6; it += NGW) {
            int r = it;
            if (r < I3) { transpose_item<0>(INP(22), 1024, 1024, 1024, (bf16*)(ws + WS_W3T), scr, r, lane); continue; } r -= I3;
            if (r < I4) { transpose_item<2>(INP(24), 1024, 2304, 2304, (bf16*)(ws + WS_W4T), scr, r, lane); continue; } r -= I4;
            transpose_item<0>(INP(28), 1024, 1024, 1024, (bf16*)(ws + WS_W6T), scr, r, lane);
        }
    }
    bf16* XN = (bf16*)(ws + WS_XN);
    if (PART == 0) for (int m = gw; m < MT; m += NGW) { const float* xr = m < MP ? INP(0) + (size_t)m * 1024 : INP(1) + (size_t)(m - MP) * 1024; rms_row(xr, INP(7), XN + (size_t)m * 1024, lane); }
    const int gt = ((int)blockIdx.x - wb0) * 512 + tid, NT = G * 512;
    if (PART == 0) for (int i = gt; i < 2048; i += NT) {
        const int g = i >> 6;
        const double lre = INP(9)[i], lim = INP(10)[i], dt = exp((double)INP(11)[g]);
        double s1, c1, s64, c64; dsincos(lim * dt, s1, c1); dsincos(lim * dt * 64.0, s64, c64);
        const double e1 = exp(lre * dt), e64 = exp(lre * dt * 64.0);
        const double lbr = e1 * c1, lbi = e1 * s1;
        ((float2*)(ws + WS_TAB + TAB_LAMB))[i] = make_float2((float)lbr, (float)lbi);
        ((float2*)(ws + WS_TAB + TAB_LAMT))[i] = make_float2((float)(e64 * c64), (float)(e64 * s64));
        const double den = lre * lre + lim * lim, nr = lbr - 1.0, ni = lbi;
        const double fr = (nr * lre + ni * lim) / den, fi = (ni * lre - nr * lim) / den;
        bf16* bbt = (bf16*)(ws + WS_TAB + TAB_BB) + (size_t)(g * 128 + (i & 63)) * 16;
        float* bbf = (float*)(ws + WS_TAB + TAB_BBF) + (size_t)i * 32;
#pragma unroll
        for (int c = 0; c < 16; ++c) { const double br = INP(12)[i * 16 + c], bi = INP(13)[i * 16 + c]; bbf[c] = (float)(fr * br - fi * bi); bbf[16 + c] = (float)(fr * bi + fi * br); bbt[c] = (bf16)f2bf((float)(fr * br - fi * bi)); bbt[64 * 16 + c] = (bf16)f2bf((float)(fr * bi + fi * br)); }
    }
    if (PART == 0) for (int i = gt; i < MT; i += NT) ((float*)(ws + WS_TAB + TAB_SS))[i] = 0.f;
    if (PART == 0) for (int i = gt; i < 65536; i += NT) { const int gc = i >> 7, k = i & 127; const float v = k < 64 ? INP(14)[gc * 64 + k] : -INP(15)[gc * 64 + k - 64]; ((bf16*)(ws + WS_TAB + TAB_CMT))[i] = (bf16)f2bf(v); }
    if (PART == 1) for (int i = gt; i < 8196 * 32; i += NT) { const int pos = i >> 5, j = i & 31; const double inv = exp(-(double)j * (9.210340371976184 / 32.0)); double s, c; dsincos((double)pos * inv, s, c);
        ((float2*)(ws + WS_ROPE))[i] = make_float2((float)c, (float)s); }
    if (PART == 1) for (int i = gt; i < 128 * 3968; i += NT) { const int seq = i / 3968, r = i % 3968;
        ((f32x4*)(P.out + OFF_SWK_S))[seq * 4096 + r] = ((const f32x4*)INP(5))[seq * 4096 + 128 + r];
        ((f32x4*)(P.out + OFF_SWV_S))[seq * 4096 + r] = ((const f32x4*)INP(6))[seq * 4096 + 128 + r]; }
}

struct EpiProj {
    static constexpr bool PERM = true, AFTER_DRAIN = false;
    bf16* O; float* alow;
    __device__ __forceinline__ void operator()(const f32x4 (&acc)[2][2][4][2], const pg8::Unit& u, int wr, int wc, int fr, int fq) const {
        const int row0 = u.pm * 256 + wr * 64 + fr;
        if (u.pn < 10) {
            const int col0 = u.pn * 256 + wc * 32 + 8 * fq;
#pragma unroll
            for (int ai = 0; ai < 2; ++ai)
#pragma unroll
                for (int m = 0; m < 4; ++m) { bf16* rowp = O + (size_t)(row0 + ai * 128 + m * 16) * LDP + col0;
#pragma unroll
                    for (int bj = 0; bj < 2; ++bj) { const f32x4 v0 = acc[ai][bj][m][0], v1 = acc[ai][bj][m][1];
                        v4u w; w.x = pk2(v0[0], v0[1]); w.y = pk2(v0[2], v0[3]); w.z = pk2(v1[0], v1[1]); w.w = pk2(v1[2], v1[3]);
                        *(v4u*)(rowp + bj * 128) = w; } }
        } else if (wc == 0 && fq < 2) {
#pragma unroll
            for (int ai = 0; ai < 2; ++ai)
#pragma unroll
                for (int m = 0; m < 4; ++m) { float* rowp = alow + (size_t)(row0 + ai * 128 + m * 16) * 16 + 8 * fq;
                    *(f32x4*)rowp = acc[ai][0][m][0]; *(f32x4*)(rowp + 4) = acc[ai][0][m][1]; }
        }
    }
};
struct EpiGlu {
    static constexpr bool PERM = true, AFTER_DRAIN = false;
    const bf16* Z; const bf16* PROJ; const float* bias; bf16* MIX;
    __device__ __forceinline__ void operator()(const f32x4 (&acc)[2][2][4][2], const pg8::Unit& u, int wr, int wc, int fr, int fq) const {
        const int row0 = u.pm * 256 + wr * 64 + fr, col0 = u.pn * 256 + wc * 32 + 8 * fq;
#pragma unroll
        for (int bj = 0; bj < 2; ++bj) { const int col = col0 + bj * 128;
            const f32x4 b0 = *(const f32x4*)(bias + col), b1 = *(const f32x4*)(bias + col + 4);
#pragma unroll
            for (int ai = 0; ai < 2; ++ai)
#pragma unroll
                for (int m = 0; m < 4; ++m) { const size_t row = (size_t)(row0 + ai * 128 + m * 16);
                    const v4u zw = *(const v4u*)(Z + row * 512 + col), gw = *(const v4u*)(PROJ + row * LDP + 512 + col);
                    float z[8], g[8], o[8]; UNPACK8(zw, z); UNPACK8(gw, g);
                    const f32x4 v0 = acc[ai][bj][m][0] + b0, v1 = acc[ai][bj][m][1] + b1;
#pragma unroll
                    for (int e = 0; e < 4; ++e) { o[e] = z[e] * sigm(v0[e]) * silu(g[e]); o[4 + e] = z[4 + e] * sigm(v1[e]) * silu(g[4 + e]); }
                    *(v4u*)(MIX + row * 1024 + col) = PACK8(o); } }
    }
};
struct EpiRes {
    static constexpr bool PERM = true, AFTER_DRAIN = false;
    const float* resA; const float* resB; float* O;
    __device__ __forceinline__ void operator()(const f32x4 (&acc)[2][2][4][2], const pg8::Unit& u, int wr, int wc, int fr, int fq) const {
        const int row0 = u.pm * 256 + wr * 64 + fr, col0 = u.pn * 256 + wc * 32 + 8 * fq;
#pragma unroll
        for (int ai = 0; ai < 2; ++ai)
#pragma unroll
            for (int m = 0; m < 4; ++m) { const int row = row0 + ai * 128 + m * 16;
                const float* rp = (row < MP ? resA + (size_t)row * 1024 : resB + (size_t)(row - MP) * 1024) + col0; float* op = O + (size_t)row * 1024 + col0;
#pragma unroll
                for (int bj = 0; bj < 2; ++bj) { const f32x4 r0 = *(const f32x4*)(rp + bj * 128), r1 = *(const f32x4*)(rp + bj * 128 + 4);
                    *(f32x4*)(op + bj * 128) = r0 + acc[ai][bj][m][0]; *(f32x4*)(op + bj * 128 + 4) = r1 + acc[ai][bj][m][1]; } }
    }
};
struct EpiResNorm {
    static constexpr bool PERM = true, AFTER_DRAIN = false;
    const float* resA; const float* resB; float* O; bf16* XN; const float* g; float* SS;
    __device__ __forceinline__ void operator()(const f32x4 (&acc)[2][2][4][2], const pg8::Unit& u, int wr, int wc, int fr, int fq) const {
        const int row0 = u.pm * 256 + wr * 64 + fr, col0 = u.pn * 256 + wc * 32 + 8 * fq;
        f32x4 gv[2][2];
#pragma unroll
        for (int bj = 0; bj < 2; ++bj) { gv[bj][0] = *(const f32x4*)(g + col0 + bj * 128); gv[bj][1] = *(const f32x4*)(g + col0 + bj * 128 + 4); }
#pragma unroll
        for (int ai = 0; ai < 2; ++ai)
#pragma unroll
            for (int m = 0; m < 4; ++m) { const int row = row0 + ai * 128 + m * 16;
                const float* rp = (row < MP ? resA + (size_t)row * 1024 : resB + (size_t)(row - MP) * 1024) + col0; float* op = O + (size_t)row * 1024 + col0;
                bf16* xp = XN + (size_t)row * 1024 + col0; float ss = 0.f;
#pragma unroll
                for (int bj = 0; bj < 2; ++bj) { const f32x4 r0 = *(const f32x4*)(rp + bj * 128), r1 = *(const f32x4*)(rp + bj * 128 + 4);
                    const f32x4 h0 = r0 + acc[ai][bj][m][0], h1 = r1 + acc[ai][bj][m][1];
                    *(f32x4*)(op + bj * 128) = h0; *(f32x4*)(op + bj * 128 + 4) = h1;
                    ss += (h0[0] * h0[0] + h0[1] * h0[1]) + (h0[2] * h0[2] + h0[3] * h0[3]) + (h1[0] * h1[0] + h1[1] * h1[1]) + (h1[2] * h1[2] + h1[3] * h1[3]);
                    const f32x4 x0 = h0 * gv[bj][0], x1 = h1 * gv[bj][1];
                    v4u w; w.x = pk2(x0[0], x0[1]); w.y = pk2(x0[2], x0[3]); w.z = pk2(x1[0], x1[1]); w.w = pk2(x1[2], x1[3]);
                    *(v4u*)(xp + bj * 128) = w; }
                ss += __shfl_xor(ss, 16); ss += __shfl_xor(ss, 32);
                if (fq == 0) atomicAdd(SS + row, ss); }
    }
};
struct EpiQKV {
    static constexpr bool PERM = true, AFTER_DRAIN = false;
    bf16* Q; bf16* KV; bf16* GT; const float* gq; const float* gk; const float2* rope; float* out; const float* SS;
    __device__ __forceinline__ void operator()(const f32x4 (&acc)[2][2][4][2], const pg8::Unit& u, int wr, int wc, int fr, int fq) const {
        const int row0 = u.pm * 256 + wr * 64 + fr;
        if (u.pn >= 5) {
            const int col0 = (u.pn - 5) * 256 + wc * 32 + 8 * fq;
#pragma unroll
            for (int ai = 0; ai < 2; ++ai)
#pragma unroll
                for (int m = 0; m < 4; ++m) { bf16* rowp = GT + (size_t)(row0 + ai * 128 + m * 16) * 1024 + col0;
                    const float rr = __builtin_amdgcn_rsqf(SS[row0 + ai * 128 + m * 16] * (1.f / 1024.f) + EPS);
#pragma unroll
                    for (int bj = 0; bj < 2; ++bj) { const f32x4 v0 = acc[ai][bj][m][0] * rr, v1 = acc[ai][bj][m][1] * rr;
                        v4u w; w.x = pk2(v0[0], v0[1]); w.y = pk2(v0[2], v0[3]); w.z = pk2(v1[0], v1[1]); w.w = pk2(v1[2], v1[3]);
                        *(v4u*)(rowp + bj * 128) = w; } }
            return;
        }
        const int head = 4 * u.pn + wc;
        const bool isv = head >= 18;
        const float* gsrc = head < 16 ? gq : gk;
        f32x4 gw[2][2];
#pragma unroll
        for (int bj = 0; bj < 2; ++bj)
#pragma unroll
            for (int n = 0; n < 2; ++n) gw[bj][n] = *(const f32x4*)(gsrc + 32 * bj + 8 * fq + 4 * n);
#pragma unroll
        for (int ai = 0; ai < 2; ++ai)
#pragma unroll
            for (int m = 0; m < 4; ++m) {
                const int row = row0 + ai * 128 + m * 16;
                const int pos = row < MP ? (row & 8191) : 8192 + ((row - MP) & 3);
                const float rr = __builtin_amdgcn_rsqf(SS[row] * (1.f / 1024.f) + EPS);
                f32x4 o[2][2];
                if (!isv) {
                    float ss = 0.f;
#pragma unroll
                    for (int bj = 0; bj < 2; ++bj)
#pragma unroll
                        for (int n = 0; n < 2; ++n) { const f32x4 a = acc[ai][bj][m][n]; ss += (a[0] * a[0] + a[1] * a[1]) + (a[2] * a[2] + a[3] * a[3]); }
                    ss += __shfl_xor(ss, 16); ss += __shfl_xor(ss, 32);
                    const float rs = rr * __builtin_amdgcn_rsqf(ss * (rr * rr) * (1.f / 64.f) + EPS);
#pragma unroll
                    for (int n = 0; n < 2; ++n) { const f32x4 x1 = acc[ai][0][m][n] * rs * gw[0][n], x2 = acc[ai][1][m][n] * rs * gw[1][n];
                        const float2* rp = rope + (size_t)pos * 32 + 8 * fq + 4 * n;
#pragma unroll
                        for (int e = 0; e < 4; ++e) { const float2 cs = rp[e]; o[0][n][e] = x1[e] * cs.x - x2[e] * cs.y; o[1][n][e] = x2[e] * cs.x + x1[e] * cs.y; } }
                } else {
#pragma unroll
                    for (int bj = 0; bj < 2; ++bj)
#pragma unroll
                        for (int n = 0; n < 2; ++n) o[bj][n] = acc[ai][bj][m][n] * rr;
                }
                if (head < 16) {
#pragma unroll
                    for (int bj = 0; bj < 2; ++bj) { const f32x4 v0 = o[bj][0] * 0.18033688011112042f, v1 = o[bj][1] * 0.18033688011112042f;
                        v4u w; w.x = pk2(v0[0], v0[1]); w.y = pk2(v0[2], v0[3]); w.z = pk2(v1[0], v1[1]); w.w = pk2(v1[2], v1[3]);
                        *(v4u*)(Q + (size_t)row * 1024 + head * 64 + 32 * bj + 8 * fq) = w; }
                } else {
                    const int kvi = head - 16, kvh = kvi & 1;
                    float* cdst = nullptr;
                    if (row < MP) { if (pos >= 8064) cdst = out + (kvi < 2 ? OFF_SWK_P : OFF_SWV_P) + (((row >> 13) * 128 + pos - 8064) * 2 + kvh) * 64; }
                    else { const int sq = (row - MP) >> 2, t = (row - MP) & 3; cdst = out + (kvi < 2 ? OFF_SWK_S : OFF_SWV_S) + ((sq * 128 + 124 + t) * 2 + kvh) * 64; }
#pragma unroll
                    for (int bj = 0; bj < 2; ++bj) { const f32x4 v0 = o[bj][0], v1 = o[bj][1];
                        v4u w; w.x = pk2(v0[0], v0[1]); w.y = pk2(v0[2], v0[3]); w.z = pk2(v1[0], v1[1]); w.w = pk2(v1[2], v1[3]);
                        *(v4u*)(KV + (size_t)row * 256 + kvi * 64 + 32 * bj + 8 * fq) = w;
                        if (cdst) { *(f32x4*)(cdst + 32 * bj + 8 * fq) = v0; *(f32x4*)(cdst + 32 * bj + 8 * fq + 4) = v1; } }
                }
            }
    }
};

__device__ __forceinline__ void s5_decode(int it, int& g, int& row0, int& T) {
    if (it < 8192) { g = it & 31; const int ch = (it >> 5) & 127, n = it >> 12; row0 = n * 8192 + ch * 64; T = 64; }
    else { const int j = it - 8192; g = j & 31; row0 = MP + (j >> 5) * 4; T = 4; }
}
__device__ __forceinline__ void s5_load_u(const bf16* PROJ, int it, int lane, bf16x8 (&ua)[4]) {
    int g, row0, T; s5_decode(it, g, row0, T);
    const int fr = lane & 15, fq = lane >> 4;
#pragma unroll
    for (int tile = 0; tile < 4; ++tile) { const int t = 16 * tile + fr; bf16x8 v = {0, 0, 0, 0, 0, 0, 0, 0};
        if (fq < 2 && t < T) v = *(const bf16x8*)(PROJ + (size_t)(row0 + t) * LDP + g * 16 + 8 * fq);
        ua[tile] = v; }
}
template <bool OUT> __device__ __forceinline__ void s5_item(const Params& P, int it, int lane, LAS float* BU, LAS bf16* XS, const bf16x8 (&ua)[4]) {
    unsigned char* ws = P.ws;
    int g, row0, T; s5_decode(it, g, row0, T);
    const bool prompt = it < 8192; const int seq = prompt ? (it >> 12) : ((it - 8192) >> 5); const bool lastc = prompt && (((it >> 5) & 127) == 127);
    const int slot = (it >> 5) * 2048 + g * 64 + lane;
    const int gp = g * 64 + lane, fr = lane & 15, fq = lane >> 4;
    const float2 lam = ((const float2*)(ws + WS_TAB + TAB_LAMB))[gp];
    bf16x8 bb[8];
#pragma unroll
    for (int jt = 0; jt < 8; ++jt) { bf16x8 v = {0, 0, 0, 0, 0, 0, 0, 0}; if (fq < 2) v = *(const bf16x8*)((const bf16*)(ws + WS_TAB + TAB_BB) + (size_t)(g * 128 + 16 * jt + fr) * 16 + 8 * fq); bb[jt] = v; }
    bf16x8 bfr[4], dg;
    if (OUT) {
        const bf16* cm = (const bf16*)(ws + WS_TAB + TAB_CMT) + (size_t)(g * 16 + fr) * 128 + 8 * fq;
#pragma unroll
        for (int s = 0; s < 4; ++s) bfr[s] = *(const bf16x8*)(cm + 32 * s);
        const short d16 = (short)f2bf(INP(16)[g * 16 + fr]);
#pragma unroll
        for (int j = 0; j < 8; ++j) dg[j] = (8 * fq + j == fr) ? d16 : (short)0;
    }
    float xr = 0.f, xi = 0.f;
    if (OUT) { if (prompt) { const float2 x0 = ((const float2*)(ws + WS_XIN))[slot]; xr = x0.x; xi = x0.y; } else { xr = INP(2)[(seq * 32 + g) * 64 + lane]; xi = INP(3)[(seq * 32 + g) * 64 + lane]; } }
    bf16* Z = (bf16*)(ws + WS_Z);
    const int ntile = (T + 15) >> 4;
#pragma unroll
    for (int tile = 0; tile < 4; ++tile) {
        if (tile < ntile) {
            f32x4 accs[8];
#pragma unroll
            for (int jt = 0; jt < 8; ++jt) { accs[jt] = MFMA16(ua[tile], bb[jt], zacc()); }
            __builtin_amdgcn_sched_barrier(0); asm volatile("s_nop 15\n\ts_nop 15" ::: "memory"); __builtin_amdgcn_sched_barrier(0);
#pragma unroll
            for (int jt = 0; jt < 8; ++jt)
#pragma unroll
                for (int r = 0; r < 4; ++r) BU[(4 * fq + r) * 130 + 16 * jt + fr] = accs[jt][r];
            LDS_WAIT();
            if (T == 64) {
#pragma unroll
                for (int t = 0; t < 16; ++t) { float br = BU[t * 130 + lane], bi = BU[t * 130 + 64 + lane];

                    const float nr = lam.x * xr - lam.y * xi + br, ni = lam.x * xi + lam.y * xr + bi; xr = nr; xi = ni;
                    if (OUT) { const unsigned pk = pk2(xr, xi); XS[t * 136 + lane] = (bf16)(pk & 0xffffu); XS[t * 136 + 64 + lane] = (bf16)(pk >> 16); } }
            } else {
#pragma unroll
                for (int t = 0; t < 4; ++t) { const float br = BU[t * 130 + lane], bi = BU[t * 130 + 64 + lane];
                    const float nr = lam.x * xr - lam.y * xi + br, ni = lam.x * xi + lam.y * xr + bi; xr = nr; xi = ni;
                    if (OUT) { const unsigned pk = pk2(xr, xi); XS[t * 136 + lane] = (bf16)(pk & 0xffffu); XS[t * 136 + 64 + lane] = (bf16)(pk >> 16); } }
            }
            if (OUT) {
                LDS_WAIT();
                f32x4 y = zacc();
#pragma unroll
                for (int s = 0; s < 4; ++s) { const bf16x8 a = *(const LAS bf16x8*)(XS + fr * 136 + 32 * s + 8 * fq); y = MFMA16(a, bfr[s], y); }
                y = MFMA16(ua[tile], dg, y);
#pragma unroll
                for (int r = 0; r < 4; ++r) { const int t = 16 * tile + 4 * fq + r; if (t < T) Z[(size_t)(row0 + t) * 512 + g * 16 + fr] = (bf16)f2bf(gelu_tanh(y[r])); }
            }
            LDS_WAIT();
        }
    }
    if (!OUT) { ((float2*)(ws + WS_LOC))[slot] = make_float2(xr, xi); return; }
    if (prompt) { if (lastc) { P.out[OFF_S5RE_P + (seq * 32 + g) * 64 + lane] = xr; P.out[OFF_S5IM_P + (seq * 32 + g) * 64 + lane] = xi; } }
    else { P.out[OFF_S5RE_S + (seq * 32 + g) * 64 + lane] = xr; P.out[OFF_S5IM_S + (seq * 32 + g) * 64 + lane] = xi; }
}
template <bool OUT> __device__ __forceinline__ void s5_loop(const Params& P, int nitems, int gw, int NGW, int lane, LAS unsigned char* wlds) {
    const bf16* PROJ = (const bf16*)(P.ws + WS_PROJ);
    LAS float* BU = (LAS float*)wlds; LAS bf16* XS = (LAS bf16*)(wlds + 8320);
    bf16x8 ua[4];
    for (int it = gw; it < nitems; it += NGW) {
        s5_load_u(PROJ, it, lane, ua);
        s5_item<OUT>(P, it, lane, BU, XS, ua);
    }
}

template <bool OUT> __device__ __forceinline__ void s5_item_old(const Params& P, int it, int lane, LAS bf16* XS) {
    unsigned char* ws = P.ws;
    const bf16* PROJ = (const bf16*)(ws + WS_PROJ);
    int g, row0, T, slot = 0, seq = 0; bool prompt = true, lastc = false;
    if (it < 8192) { g = it & 31; const int ch = (it >> 5) & 127, n = it >> 12; row0 = n * 8192 + ch * 64; T = 64; slot = ((n * 128 + ch) * 32 + g) * 64 + lane; lastc = (ch == 127); seq = n; }
    else { const int j = it - 8192; g = j & 31; seq = j >> 5; row0 = MP + seq * 4; T = 4; prompt = false; }
    const int gp = g * 64 + lane;
    const float2 lam = ((const float2*)(ws + WS_TAB + TAB_LAMB))[gp];
    float bre[16], bim[16];
    { const f32x4* bb = (const f32x4*)((const float*)(ws + WS_TAB + TAB_BBF) + (size_t)gp * 32);
#pragma unroll
      for (int q = 0; q < 4; ++q) { const f32x4 a = bb[q], b = bb[4 + q];
#pragma unroll
          for (int e = 0; e < 4; ++e) { bre[4 * q + e] = a[e]; bim[4 * q + e] = b[e]; } } }
    float xr = 0.f, xi = 0.f;
    if (OUT) { if (prompt) { const float2 x0 = ((const float2*)(ws + WS_XIN))[slot]; xr = x0.x; xi = x0.y; } else { xr = INP(2)[(seq * 32 + g) * 64 + lane]; xi = INP(3)[(seq * 32 + g) * 64 + lane]; } }
    const bf16* up = PROJ + (size_t)row0 * LDP + g * 16;
#pragma unroll 4
    for (int t = 0; t < T; ++t) {
        const v4u w0 = *(const v4u*)(up + (size_t)t * LDP), w1 = *(const v4u*)(up + (size_t)t * LDP + 8);
        float u[16]; UNPACK8(w0, u); { float* u8 = u + 8; UNPACK8(w1, u8); }
        float br = 0.f, bi = 0.f;
#pragma unroll
        for (int c = 0; c < 16; ++c) { br += bre[c] * u[c]; bi += bim[c] * u[c]; }
        const float nr = lam.x * xr - lam.y * xi + br, ni = lam.x * xi + lam.y * xr + bi; xr = nr; xi = ni;
        if (OUT) { XS[t * 136 + lane] = (bf16)f2bf(xr); XS[t * 136 + 64 + lane] = (bf16)f2bf(xi); }
    }
    if (!OUT) { ((float2*)(ws + WS_LOC))[slot] = make_float2(xr, xi); return; }
    if (prompt) { if (lastc) { P.out[OFF_S5RE_P + (seq * 32 + g) * 64 + lane] = xr; P.out[OFF_S5IM_P + (seq * 32 + g) * 64 + lane] = xi; } }
    else { P.out[OFF_S5RE_S + (seq * 32 + g) * 64 + lane] = xr; P.out[OFF_S5IM_S + (seq * 32 + g) * 64 + lane] = xi; }
    LDS_WAIT();
    const int fr = lane & 15, fq = lane >> 4;
    const bf16* cm = (const bf16*)(ws + WS_TAB + TAB_CMT) + (size_t)(g * 16 + fr) * 128 + 8 * fq;
    bf16x8 bfr[4];
#pragma unroll
    for (int s = 0; s < 4; ++s) bfr[s] = *(const bf16x8*)(cm + 32 * s);
    const float dv = INP(16)[g * 16 + fr];
    bf16* Z = (bf16*)(ws + WS_Z);
    const int ntile = (T + 15) >> 4;
    for (int rt = 0; rt < ntile; ++rt) {
        f32x4 acc = zacc();
#pragma unroll
        for (int s = 0; s < 4; ++s) { const bf16x8 a = *(const LAS bf16x8*)(XS + (16 * rt + fr) * 136 + 32 * s + 8 * fq); acc = MFMA16(a, bfr[s], acc); }
#pragma unroll
        for (int r = 0; r < 4; ++r) { const int t = 16 * rt + 4 * fq + r;
            if (t < T) { const size_t row = (size_t)(row0 + t); const float u = bf2f(PROJ[row * LDP + g * 16 + fr]);
                Z[row * 512 + g * 16 + fr] = (bf16)f2bf(gelu_tanh(acc[r] + dv * u)); } }
    }
    LDS_WAIT();
}


__device__ __forceinline__ void gla_decode(int item, int& h, int& row0, int& T) {
    if (item < 1024) { h = item & 3; const int ch = (item >> 2) & 127, n = item >> 9; row0 = n * 8192 + ch * 64; T = 64; }
    else { const int j = item - 1024; h = j & 3; row0 = MP + (j >> 2) * 4; T = 4; }
}
__device__ __forceinline__ void gla_passA(const Params& P, int item, LAS unsigned char* lds, int tid, int lane, int wave) {
    unsigned char* ws = P.ws;
    const bf16* PROJ = (const bf16*)(ws + WS_PROJ);
    int h, row0, T; gla_decode(item, h, row0, T);
    LAS float* LA = (LAS float*)lds; LAS bf16* KT = (LAS bf16*)(lds + 16384); LAS bf16* VT = (LAS bf16*)(lds + 25600);
    const int t = tid >> 3, kg = tid & 7, kd0 = kg * 8, v0 = kg * 16;
    const bool act = t < T;
    float la[8];
    v4u qv = {0, 0, 0, 0}, kv = {0, 0, 0, 0}, vv0 = {0, 0, 0, 0}, vv1 = {0, 0, 0, 0};
    if (act) {
        const size_t row = (size_t)(row0 + t);
        qv = *(const v4u*)(PROJ + row * LDP + 1024 + h * 64 + kd0); kv = *(const v4u*)(PROJ + row * LDP + 1280 + h * 64 + kd0);
        vv0 = *(const v4u*)(PROJ + row * LDP + 1536 + h * 128 + v0); vv1 = *(const v4u*)(PROJ + row * LDP + 1536 + h * 128 + v0 + 8);
        const f32x4* ap = (const f32x4*)((const float*)(ws + WS_ALOW) + row * 16);
        float a[16];
#pragma unroll
        for (int q = 0; q < 4; ++q) { const f32x4 x = ap[q]; a[4 * q] = x[0]; a[4 * q + 1] = x[1]; a[4 * q + 2] = x[2]; a[4 * q + 3] = x[3]; }
        const f32x4 bg0 = *(const f32x4*)(INP(20) + h * 64 + kd0), bg1 = *(const f32x4*)(INP(20) + h * 64 + kd0 + 4);
        float lg[8] = {bg0[0], bg0[1], bg0[2], bg0[3], bg1[0], bg1[1], bg1[2], bg1[3]};
#pragma unroll
        for (int r = 0; r < 16; ++r) { const f32x4 w0 = *(const f32x4*)(INP(19) + r * 256 + h * 64 + kd0), w1 = *(const f32x4*)(INP(19) + r * 256 + h * 64 + kd0 + 4);
#pragma unroll
            for (int e = 0; e < 4; ++e) { lg[e] += a[r] * w0[e]; lg[4 + e] += a[r] * w1[e]; } }
#pragma unroll
        for (int e = 0; e < 8; ++e) la[e] = (fminf(lg[e], 0.f) - log1pf(__expf(-fabsf(lg[e])))) * 0.0625f;
    } else {
#pragma unroll
        for (int e = 0; e < 8; ++e) la[e] = 0.f;
    }
    *(LAS f32x4*)(LA + t * 64 + kd0) = (f32x4){la[0], la[1], la[2], la[3]}; *(LAS f32x4*)(LA + t * 64 + kd0 + 4) = (f32x4){la[4], la[5], la[6], la[7]};
    __syncthreads();
    if (tid < 64) { float run = 0.f;
#pragma unroll 16
        for (int tt = 0; tt < 64; ++tt) { run += LA[tt * 64 + tid]; LA[tt * 64 + tid] = run; } }
    __syncthreads();
    {
        float q[8], k[8], qd[8], kd[8]; UNPACK8(qv, q); UNPACK8(kv, k);
        const f32x4 b0 = *(const LAS f32x4*)(LA + t * 64 + kd0), b1 = *(const LAS f32x4*)(LA + t * 64 + kd0 + 4);
        const f32x4 l0 = *(const LAS f32x4*)(LA + 63 * 64 + kd0), l1 = *(const LAS f32x4*)(LA + 63 * 64 + kd0 + 4);
        const float b[8] = {b0[0], b0[1], b0[2], b0[3], b1[0], b1[1], b1[2], b1[3]}, bl[8] = {l0[0], l0[1], l0[2], l0[3], l1[0], l1[1], l1[2], l1[3]};
#pragma unroll
        for (int e = 0; e < 8; ++e) { qd[e] = q[e] * 0.125f * __expf(b[e]); kd[e] = k[e] * __expf(-b[e]);
            KT[(kd0 + e) * 72 + t] = act ? (bf16)f2bf(k[e] * __expf(bl[e] - b[e])) : (bf16)0; }
        if (act) { const size_t row = (size_t)(row0 + t);
            *(v4u*)((bf16*)(ws + WS_QD) + row * 256 + h * 64 + kd0) = PACK8(qd); *(v4u*)((bf16*)(ws + WS_KDEC) + row * 256 + h * 64 + kd0) = PACK8(kd); }
        const unsigned vw[8] = {vv0.x, vv0.y, vv0.z, vv0.w, vv1.x, vv1.y, vv1.z, vv1.w};
#pragma unroll
        for (int e = 0; e < 8; ++e) { VT[(v0 + 2 * e) * 72 + t] = (bf16)(vw[e] & 0xffffu); VT[(v0 + 2 * e + 1) * 72 + t] = (bf16)(vw[e] >> 16); }
        if (tid < 64) ((float*)(ws + WS_TAB + TAB_GD))[item * 64 + tid] = __expf(LA[63 * 64 + tid]);
    }
    __syncthreads();
    {
        const int fr = lane & 15, fq = lane >> 4;
        f32x4 acc[4];
#pragma unroll
        for (int j = 0; j < 4; ++j) acc[j] = zacc();
#pragma unroll
        for (int s = 0; s < 2; ++s) { const bf16x8 a = *(const LAS bf16x8*)(VT + (16 * wave + fr) * 72 + 32 * s + 8 * fq);
#pragma unroll
            for (int j = 0; j < 4; ++j) { const bf16x8 b = *(const LAS bf16x8*)(KT + (16 * j + fr) * 72 + 32 * s + 8 * fq); acc[j] = MFMA16(a, b, acc[j]); } }
        float* ut = (float*)(ws + WS_UT) + (size_t)item * 8192;
        __builtin_amdgcn_sched_barrier(0); asm volatile("s_nop 15\n\ts_nop 15" ::: "memory"); __builtin_amdgcn_sched_barrier(0);
#pragma unroll
        for (int j = 0; j < 4; ++j)
#pragma unroll
            for (int r = 0; r < 4; ++r) ut[(16 * wave + 4 * fq + r) * 64 + 16 * j + fr] = acc[j][r];
    }
    __syncthreads();
}
__device__ __forceinline__ void gla_passB(const Params& P, int item, LAS unsigned char* lds, int tid, int lane, int wave) {
    unsigned char* ws = P.ws;
    const bf16* PROJ = (const bf16*)(ws + WS_PROJ);
    int h, row0, T; gla_decode(item, h, row0, T);
    LAS bf16* QDL = (LAS bf16*)lds; LAS bf16* KDL = (LAS bf16*)(lds + 9216); LAS bf16* VT = (LAS bf16*)(lds + 18432); LAS bf16* ATT = (LAS bf16*)(lds + 36864); LAS float* SS = (LAS float*)(lds + 46080);
    const int t = tid >> 3, kg = tid & 7, kd0 = kg * 8, v0 = kg * 16;
    const bool act = t < T;
    {
        v4u qv = {0, 0, 0, 0}, kv = {0, 0, 0, 0}, vv0 = {0, 0, 0, 0}, vv1 = {0, 0, 0, 0};
        if (act) { const size_t row = (size_t)(row0 + t);
            qv = *(const v4u*)((const bf16*)(ws + WS_QD) + row * 256 + h * 64 + kd0); kv = *(const v4u*)((const bf16*)(ws + WS_KDEC) + row * 256 + h * 64 + kd0);
            vv0 = *(const v4u*)(PROJ + row * LDP + 1536 + h * 128 + v0); vv1 = *(const v4u*)(PROJ + row * LDP + 1536 + h * 128 + v0 + 8); }
        *(LAS v4u*)(QDL + t * 72 + kd0) = qv; *(LAS v4u*)(KDL + t * 72 + kd0) = kv;
        const unsigned vw[8] = {vv0.x, vv0.y, vv0.z, vv0.w, vv1.x, vv1.y, vv1.z, vv1.w};
#pragma unroll
        for (int e = 0; e < 8; ++e) { VT[(v0 + 2 * e) * 72 + t] = (bf16)(vw[e] & 0xffffu); VT[(v0 + 2 * e + 1) * 72 + t] = (bf16)(vw[e] >> 16); }
    }
    __syncthreads();
    const int fr = lane & 15, fq = lane >> 4;
    {
        const int i = wave >> 1;
#pragma unroll
        for (int jj = 0; jj < 2; ++jj) { const int j = 2 * (wave & 1) + jj;
            f32x4 acc = zacc();
            if (j <= i) {
#pragma unroll
                for (int s = 0; s < 2; ++s) { const bf16x8 a = *(const LAS bf16x8*)(QDL + (16 * i + fr) * 72 + 32 * s + 8 * fq), b = *(const LAS bf16x8*)(KDL + (16 * j + fr) * 72 + 32 * s + 8 * fq); acc = MFMA16(a, b, acc); }
            }
#pragma unroll
            for (int r = 0; r < 4; ++r) { const int rr = 16 * i + 4 * fq + r, cc = 16 * j + fr; const bool keep = (j < i) || (j == i && cc <= rr);
                ATT[rr * 72 + cc] = keep ? (bf16)f2bf(acc[r]) : (bf16)0; } }
    }
    __syncthreads();
    f32x4 acc[4];
#pragma unroll
    for (int i = 0; i < 4; ++i) acc[i] = zacc();
    {
        const bf16* st = (const bf16*)(ws + WS_ST) + (size_t)item * 8192 + (size_t)(16 * wave + fr) * 64 + 8 * fq;
#pragma unroll
        for (int s = 0; s < 2; ++s) { const bf16x8 bV = *(const LAS bf16x8*)(VT + (16 * wave + fr) * 72 + 32 * s + 8 * fq); const bf16x8 bS = *(const bf16x8*)(st + 32 * s);
#pragma unroll
            for (int i = 0; i < 4; ++i) { const bf16x8 aA = *(const LAS bf16x8*)(ATT + (16 * i + fr) * 72 + 32 * s + 8 * fq), aQ = *(const LAS bf16x8*)(QDL + (16 * i + fr) * 72 + 32 * s + 8 * fq);
                acc[i] = MFMA16(aA, bV, acc[i]); acc[i] = MFMA16(aQ, bS, acc[i]); } }
    }
#pragma unroll
    for (int i = 0; i < 4; ++i)
#pragma unroll
        for (int r = 0; r < 4; ++r) { float sq = acc[i][r] * acc[i][r]; sq += __shfl_xor(sq, 1); sq += __shfl_xor(sq, 2); sq += __shfl_xor(sq, 4); sq += __shfl_xor(sq, 8);
            if (fr == 0) SS[wave * 64 + 16 * i + 4 * fq + r] = sq; }
    __syncthreads();
    {
        const float gn = INP(21)[16 * wave + fr];
        bf16* MIX = (bf16*)(ws + WS_MIX);
#pragma unroll
        for (int i = 0; i < 4; ++i)
#pragma unroll
            for (int r = 0; r < 4; ++r) { const int tt = 16 * i + 4 * fq + r;
                if (tt < T) { float tot = 0.f;
#pragma unroll
                    for (int w = 0; w < 8; ++w) tot += SS[w * 64 + tt];
                    const float rs = __builtin_amdgcn_rsqf(tot * (1.f / 128.f) + EPS);
                    const size_t row = (size_t)(row0 + tt); const int col = h * 128 + 16 * wave + fr;
                    const float gb = bf2f(PROJ[row * LDP + 2048 + col]);
                    MIX[row * 1024 + 512 + col] = (bf16)f2bf(acc[i][r] * rs * gn * silu(gb)); } }
    }
    __syncthreads();
}

__device__ __forceinline__ void phase3(const Params& P, LAS unsigned char* lds, int tid) {
    unsigned char* ws = P.ws; const int G = gridDim.x;
    const float* GD = (const float*)(ws + WS_TAB + TAB_GD);
    for (int b = blockIdx.x; b < 136; b += G) {
        if (b < 8) {
            const int i = b * 512 + tid, n = i >> 11, gp = i & 2047;
            const float2 lt = ((const float2*)(ws + WS_TAB + TAB_LAMT))[gp];
            const float2* loc = (const float2*)(ws + WS_LOC) + (size_t)n * 128 * 2048 + gp; float2* xin = (float2*)(ws + WS_XIN) + (size_t)n * 128 * 2048 + gp;
            float xr = 0.f, xi = 0.f;
#pragma unroll 16
            for (int c = 0; c < 128; ++c) { float2 l = loc[(size_t)c * 2048];  xin[(size_t)c * 2048] = make_float2(xr, xi);
                const float nr = lt.x * xr - lt.y * xi + l.x, ni = lt.x * xi + lt.y * xr + l.y; xr = nr; xi = ni; }
        } else {
            const int i = (b - 8) * 512 + tid, kd = i & 63, v = (i >> 6) & 127, h = (i >> 13) & 3, n = i >> 15;
            float S = 0.f;
#pragma unroll 16
            for (int c = 0; c < 128; ++c) { const int item = (n * 128 + c) * 4 + h; const size_t off = (size_t)item * 8192 + v * 64 + kd;
                const float uu = ((const float*)(ws + WS_UT))[off], d = GD[item * 64 + kd];
                ((bf16*)(ws + WS_ST))[off] = (bf16)f2bf(S); S = d * S + uu; }
            P.out[OFF_GLA_P + ((n * 4 + h) * 64 + kd) * 128 + v] = S;
        }
    }
    LAS float* tile = (LAS float*)lds;
    for (int j = blockIdx.x; j < 512; j += G) {
        const int item = 1024 + j; const size_t base = (size_t)j * 8192;
#pragma unroll
        for (int i = 0; i < 16; ++i) { const int e = tid + 512 * i; tile[(e >> 7) * 129 + (e & 127)] = INP(4)[base + e]; }
        __syncthreads();
#pragma unroll
        for (int i = 0; i < 16; ++i) { const int e = tid + 512 * i, v = e >> 6, kd = e & 63; const float sin_ = tile[kd * 129 + v];
            const size_t off = (size_t)item * 8192 + e;
            ((bf16*)(ws + WS_ST))[off] = (bf16)f2bf(sin_);
            tile[kd * 129 + v] = GD[item * 64 + kd] * sin_ + ((const float*)(ws + WS_UT))[off]; }
        __syncthreads();
#pragma unroll
        for (int i = 0; i < 16; ++i) { const int e = tid + 512 * i; P.out[OFF_GLA_S + base + e] = tile[(e >> 7) * 129 + (e & 127)]; }
        __syncthreads();
    }
}

__device__ __forceinline__ void attn_prompt(const Params& P, int item, LAS unsigned char* lds, int tid, int lane, int wave) {
    unsigned char* ws = P.ws;
    const bf16* Q = (const bf16*)(ws + WS_Q); const bf16* KV = (const bf16*)(ws + WS_KV); const bf16* GT = (const bf16*)(ws + WS_GATE); bf16* AO = (bf16*)(ws + WS_XN);
    const int qb = item & 63, kvh = (item >> 6) & 1, n = item >> 7;
    LAS bf16* KL = (LAS bf16*)lds; LAS bf16* VTL = (LAS bf16*)(lds + 36864); LAS bf16* PW = (LAS bf16*)(lds + 72704 + wave * 5440);
    LAS float* OS = (LAS float*)PW;
    const int head = kvh * 8 + wave, fr = lane & 15, fq = lane >> 4;
    const bf16* qbase = Q + (size_t)(n * 8192 + qb * 128 + fr) * 1024 + head * 64 + 8 * fq;
    bf16x8 aqc[2], aqn[2];
#pragma unroll
    for (int s = 0; s < 2; ++s) aqc[s] = *(const bf16x8*)(qbase + 32 * s);
    const int kr0 = n * 8192 + (qb - 1) * 128;
#pragma unroll
    for (int i = 0; i < 4; ++i) { const int c = tid + 512 * i;
        { const int key = c >> 3, part = c & 7; v4u kk = {0, 0, 0, 0}; if (qb > 0 || key >= 128) kk = *(const v4u*)(KV + (size_t)(kr0 + key) * 256 + kvh * 64 + part * 8); *(LAS v4u*)(KL + key * 72 + part * 8) = kk; }
        { const int key = c & 255, part = c >> 8; v4u vv = {0, 0, 0, 0}; if (qb > 0 || key >= 128) vv = *(const v4u*)(KV + (size_t)(kr0 + key) * 256 + 128 + kvh * 64 + part * 8);
            const unsigned vw[4] = {vv.x, vv.y, vv.z, vv.w};
#pragma unroll
            for (int e = 0; e < 4; ++e) { VTL[(part * 8 + 2 * e) * 280 + key] = (bf16)(vw[e] & 0xffffu); VTL[(part * 8 + 2 * e + 1) * 280 + key] = (bf16)(vw[e] >> 16); } } }
    for (int e = tid; e < 1024; e += 512) VTL[(e >> 4) * 280 + 256 + (e & 15)] = (bf16)0;
    __syncthreads();
    const float sink = INP(27)[head] * 1.4426950408889634f;
    for (int sb = 0; sb < 8; ++sb) {
        const int orow = lane >> 2, oseg = lane & 3;
        const size_t grow = (size_t)(n * 8192 + qb * 128 + 16 * sb + orow) * 1024 + head * 64 + 16 * oseg;
        const v4u g0 = *(const v4u*)(GT + grow), g1 = *(const v4u*)(GT + grow + 8);
        { const int sbn = sb < 7 ? sb + 1 : 7;
#pragma unroll
          for (int s = 0; s < 2; ++s) aqn[s] = *(const bf16x8*)(qbase + (size_t)(16 * sbn) * 1024 + 32 * s); }
        f32x4 sc[9];
#pragma unroll
        for (int kt = 0; kt < 9; ++kt) { sc[kt] = zacc();
#pragma unroll
            for (int s = 0; s < 2; ++s) { const bf16x8 b = *(const LAS bf16x8*)(KL + (16 * (sb + kt) + fr) * 72 + 32 * s + 8 * fq); sc[kt] = MFMA16(aqc[s], b, sc[kt]); } }
        aqc[0] = aqn[0]; aqc[1] = aqn[1];
        for (int e = lane; e < 384; e += 64) PW[(e / 24) * 168 + 144 + (e % 24)] = (bf16)0;
        float mx[4], sum[4];
#pragma unroll
        for (int r = 0; r < 4; ++r) { const int qi = 16 * sb + 4 * fq + r; float m = -3.0e38f;
#pragma unroll
            for (int kt = 0; kt < 9; ++kt) { const int kj = 16 * (sb + kt) + fr;
                const bool ok = (kt == 0 ? (kj > qi) : (kt == 8 ? (kj <= qi + 128) : true)) && (qb > 0 || kj >= 128);
                sc[kt][r] = ok ? sc[kt][r] : -3.0e38f; m = fmaxf(m, sc[kt][r]); }
            m = fmaxf(m, __shfl_xor(m, 1)); m = fmaxf(m, __shfl_xor(m, 2)); m = fmaxf(m, __shfl_xor(m, 4)); m = fmaxf(m, __shfl_xor(m, 8));
            mx[r] = fmaxf(m, sink); }
#pragma unroll
        for (int r = 0; r < 4; ++r) { float sm = 0.f;
#pragma unroll
            for (int kt = 0; kt < 9; ++kt) { const float pv = __builtin_amdgcn_exp2f(sc[kt][r] - mx[r]); sm += pv; PW[(4 * fq + r) * 168 + 16 * kt + fr] = (bf16)f2bf(pv); }
            sm += __shfl_xor(sm, 1); sm += __shfl_xor(sm, 2); sm += __shfl_xor(sm, 4); sm += __shfl_xor(sm, 8);
            sum[r] = __builtin_amdgcn_rcpf(sm + __builtin_amdgcn_exp2f(sink - mx[r])); }
        LDS_WAIT();
        f32x4 oa[4];
#pragma unroll
        for (int dt = 0; dt < 4; ++dt) oa[dt] = zacc();
#pragma unroll
        for (int s = 0; s < 5; ++s) { const bf16x8 a = *(const LAS bf16x8*)(PW + fr * 168 + 32 * s + 8 * fq);
#pragma unroll
            for (int dt = 0; dt < 4; ++dt) { const bf16x8 b = *(const LAS bf16x8*)(VTL + (16 * dt + fr) * 280 + 16 * sb + 32 * s + 8 * fq); oa[dt] = MFMA16(a, b, oa[dt]); } }
        LDS_WAIT();
        __builtin_amdgcn_sched_barrier(0); asm volatile("s_nop 15\n\ts_nop 15" ::: "memory"); __builtin_amdgcn_sched_barrier(0);
#pragma unroll
        for (int r = 0; r < 4; ++r) {
#pragma unroll
            for (int dt = 0; dt < 4; ++dt) OS[(4 * fq + r) * 68 + 16 * dt + fr] = oa[dt][r];
            if (fr == 0) OS[16 * 68 + 4 * fq + r] = sum[r]; }
        LDS_WAIT();
        {
            const float inv = OS[16 * 68 + orow];
            float gg[16]; UNPACK8(g0, gg); { float* g8 = gg + 8; UNPACK8(g1, g8); }
            float ov[16];
#pragma unroll
            for (int q4 = 0; q4 < 4; ++q4) { const f32x4 x = *(const LAS f32x4*)(OS + orow * 68 + 16 * oseg + 4 * q4);
#pragma unroll
                for (int e = 0; e < 4; ++e) ov[4 * q4 + e] = x[e] * inv * silu(gg[4 * q4 + e]); }
            *(v4u*)(AO + grow) = PACK8(ov); { const float* o8 = ov + 8; *(v4u*)(AO + grow + 8) = PACK8(o8); }
        }
        LDS_WAIT();
    }
    __syncthreads();
}
__device__ __forceinline__ void attn_sample(const Params& P, int item, LAS unsigned char* lds, int tid, int lane, int wave) {
    unsigned char* ws = P.ws;
    const bf16* Q = (const bf16*)(ws + WS_Q); const bf16* KV = (const bf16*)(ws + WS_KV); const bf16* GT = (const bf16*)(ws + WS_GATE); bf16* AO = (bf16*)(ws + WS_XN);
    const int seq = item >> 1, kvh = item & 1, head = kvh * 8 + wave;
    LAS float* KS = (LAS float*)lds; LAS float* VS = (LAS float*)(lds + 34336); LAS float* QS = (LAS float*)(lds + 68144) + wave * 256; LAS float* PS = (LAS float*)(lds + 76336) + wave * 544;
    const size_t R0 = (size_t)(MP + seq * 4);
    const float* kc = INP(5) + ((size_t)(seq * 128) * 2 + kvh) * 64; const float* vc = INP(6) + ((size_t)(seq * 128) * 2 + kvh) * 64;
#pragma unroll
    for (int i = 0; i < 4; ++i) { const int c = tid + 512 * i, key = c >> 4, p4 = c & 15;
        const f32x4 kx = *(const f32x4*)(kc + (size_t)key * 128 + 4 * p4), vx = *(const f32x4*)(vc + (size_t)key * 128 + 4 * p4);
        KS[key * 65 + 4 * p4] = kx[0]; KS[key * 65 + 4 * p4 + 1] = kx[1]; KS[key * 65 + 4 * p4 + 2] = kx[2]; KS[key * 65 + 4 * p4 + 3] = kx[3];
        *(LAS f32x4*)(VS + key * 64 + 4 * p4) = vx; }
    if (tid < 256) { const int key = tid >> 6, d = tid & 63; KS[(128 + key) * 65 + d] = bf2f(KV[(R0 + key) * 256 + kvh * 64 + d]); VS[(128 + key) * 64 + d] = bf2f(KV[(R0 + key) * 256 + 128 + kvh * 64 + d]); }
#pragma unroll
    for (int t = 0; t < 4; ++t) QS[t * 64 + lane] = bf2f(Q[(R0 + t) * 1024 + head * 64 + lane]);
    const float gt[4] = {bf2f(GT[(R0 + 0) * 1024 + head * 64 + lane]), bf2f(GT[(R0 + 1) * 1024 + head * 64 + lane]), bf2f(GT[(R0 + 2) * 1024 + head * 64 + lane]), bf2f(GT[(R0 + 3) * 1024 + head * 64 + lane])};
    __syncthreads();
    const float sink = INP(27)[head] * 1.4426950408889634f;
    float s[3][4];
#pragma unroll
    for (int kk = 0; kk < 3; ++kk)
#pragma unroll
        for (int t = 0; t < 4; ++t) s[kk][t] = 0.f;
    const int k2 = (lane < 4) ? 128 + lane : 0;
#pragma unroll 4
    for (int d4 = 0; d4 < 16; ++d4) {
        f32x4 qx[4];
#pragma unroll
        for (int t = 0; t < 4; ++t) qx[t] = *(const LAS f32x4*)(QS + t * 64 + 4 * d4);
#pragma unroll
        for (int e = 0; e < 4; ++e) { const float ka = KS[lane * 65 + 4 * d4 + e], kb = KS[(lane + 64) * 65 + 4 * d4 + e], kc2 = KS[k2 * 65 + 4 * d4 + e];
#pragma unroll
            for (int t = 0; t < 4; ++t) { s[0][t] += ka * qx[t][e]; s[1][t] += kb * qx[t][e]; s[2][t] += kc2 * qx[t][e]; } }
    }
    float inv[4];
#pragma unroll
    for (int t = 0; t < 4; ++t) {
        bool ok[3]; ok[0] = lane > t; ok[1] = true; ok[2] = (lane < 4) && (lane <= t);
        float m = -3.0e38f;
#pragma unroll
        for (int kk = 0; kk < 3; ++kk) m = ok[kk] ? fmaxf(m, s[kk][t]) : m;
        m = fmaxf(wave_max(m), sink);
        float sm = 0.f;
#pragma unroll
        for (int kk = 0; kk < 3; ++kk) { const float pv = ok[kk] ? __builtin_amdgcn_exp2f(s[kk][t] - m) : 0.f; sm += pv; if (kk < 2 || lane < 4) PS[(lane + 64 * kk) * 4 + t] = pv; }
        sm = wave_sum(sm) + __builtin_amdgcn_exp2f(sink - m);
        inv[t] = 1.f / sm;
    }
    LDS_WAIT();
    float o[4] = {0.f, 0.f, 0.f, 0.f};
#pragma unroll 4
    for (int key = 0; key < 132; ++key) { const float vx = VS[key * 64 + lane]; const f32x4 pp = *(const LAS f32x4*)(PS + key * 4);
#pragma unroll
        for (int t = 0; t < 4; ++t) o[t] += pp[t] * vx; }
#pragma unroll
    for (int t = 0; t < 4; ++t) AO[(R0 + t) * 1024 + head * 64 + lane] = (bf16)f2bf(o[t] * inv[t] * silu(gt[t]));
    __syncthreads();
}

__device__ __forceinline__ int fresh_tid() { int t = threadIdx.x; asm volatile("" : "+v"(t)); return t; }
__device__ __forceinline__ unsigned char* fresh_ptr(unsigned char* p) { asm volatile("" : "+s"(p)); return p; }
#define FRESH_IDS const int tid = fresh_tid(), lane = tid & 63, wave = __builtin_amdgcn_readfirstlane(tid >> 6), G = gridDim.x, bid = blockIdx.x, gw = bid * 8 + wave, NGW = G * 8; \
    unsigned char* ws = fresh_ptr(P.ws); LAS unsigned char* lds = lds0(); (void)lane; (void)gw; (void)NGW; (void)ws; (void)lds; (void)G; (void)bid;
#define GSYNC() do { XcdBarrier xb_; xb_.bar = (unsigned*)(fresh_ptr(P.ws) + WS_BAR); xb_.x = xb_xcc_id(); xb_.st = (volatile LAS unsigned*)(lds0() + LDS_BYTES - 64); xcd_barrier(xb_); } while (0)
__global__ void __launch_bounds__(512, 2) hybrid_fwd(Params P) {
    typedef pg8::StaticOrder SO;
    {
        FRESH_IDS
        volatile LAS unsigned* bst = (volatile LAS unsigned*)(lds + LDS_BYTES - 64);
        if (tid == 0) { bst[0] = 0u; bst[1] = 0u; }
        if (tid < 29) ((LAS unsigned long long*)(lds + PTAB_OFF))[tid] = (unsigned long long)P.in[tid];
        __syncthreads();
        (void)xcd_barrier_post((unsigned*)(ws + WS_BAR), bst);
        if (P.out == nullptr) cg::this_grid().sync();
        phase0<0>(P, lds, tid, lane, wave, 0);
    }
    GSYNC();
    {
        FRESH_IDS
        pg8::Gemm g{(const pg8::bf16_t*)(ws + WS_XN), (const pg8::bf16_t*)(ws + WS_W1T), MT, 2816, 1024}; SO S; S.init(MT, 2816, G, bid);
        EpiProj E{(bf16*)(ws + WS_PROJ), (float*)(ws + WS_ALOW)};
        pg8::gemm_phase<EpiProj, SO, true, true>(lds, g, S, E);
    }
    GSYNC();
    {
        FRESH_IDS
        s5_loop<false>(P, 8192, gw, NGW, lane, lds + wave * 12800);
        __syncthreads();
        for (int it = bid; it < 1536; it += G) gla_passA(P, it, lds, tid, lane, wave);
    }
    GSYNC();
    { FRESH_IDS phase3(P, lds, tid); }
    GSYNC();
    {
        FRESH_IDS
        s5_loop<true>(P, 12288, gw, NGW, lane, lds + wave * 12800);
        __syncthreads();
        for (int it = bid; it < 1536; it += G) gla_passB(P, it, lds, tid, lane, wave);
    }
    GSYNC();
    {
        FRESH_IDS
        pg8::Gemm g{(const pg8::bf16_t*)(ws + WS_Z), (const pg8::bf16_t*)(ws + WS_WGT), MT, 512, 512}; SO S; S.init(MT, 512, G, bid);
        EpiGlu E{(const bf16*)(ws + WS_Z), (const bf16*)(ws + WS_PROJ), INP(18), (bf16*)(ws + WS_MIX)};
        constexpr int NGLU = (MT / 256) * 2;
        if (bid < NGLU || G <= NGLU) pg8::gemm_phase<EpiGlu, SO, true, true>(lds, g, S, E);
        if (G <= NGLU) { __syncthreads(); phase0<1>(P, lds, tid, lane, wave, 0); }
        else if (bid >= NGLU) phase0<1>(P, lds, tid, lane, wave, NGLU);
    }
    GSYNC();
    {
        FRESH_IDS
        pg8::Gemm g{(const pg8::bf16_t*)(ws + WS_MIX), (const pg8::bf16_t*)(ws + WS_W3T), MT, 1024, 1024}; SO S; S.init(MT, 1024, G, bid);
        EpiResNorm E{INP(0), INP(1), (float*)(ws + WS_PROJ), (bf16*)(ws + WS_XN), INP(23), (float*)(ws + WS_TAB + TAB_SS)};
        pg8::gemm_phase<EpiResNorm, SO, true, true>(lds, g, S, E);
    }
    GSYNC();
    {
        FRESH_IDS
        pg8::Gemm g{(const pg8::bf16_t*)(ws + WS_XN), (const pg8::bf16_t*)(ws + WS_W4T), MT, 2304, 1024}; SO S; S.init(MT, 2304, G, bid);
        EpiQKV E{(bf16*)(ws + WS_Q), (bf16*)(ws + WS_KV), (bf16*)(ws + WS_GATE), INP(25), INP(26), (const float2*)(ws + WS_ROPE), P.out, (const float*)(ws + WS_TAB + TAB_SS)};
        pg8::gemm_phase<EpiQKV, SO, true, true>(lds, g, S, E);
    }
    GSYNC();
    {
        FRESH_IDS
        for (int it = bid; it < 256; it += G) attn_prompt(P, it, lds, tid, lane, wave);
        for (int it = bid; it < 256; it += G) attn_sample(P, it, lds, tid, lane, wave);
    }
    GSYNC();
    {
        FRESH_IDS
        pg8::Gemm g{(const pg8::bf16_t*)(ws + WS_XN), (const pg8::bf16_t*)(ws + WS_W6T), MT, 1024, 1024}; SO S; S.init(MT, 1024, G, bid);
        const float* H1 = (const float*)(ws + WS_PROJ);
        EpiRes E{H1, H1 + (size_t)MP * 1024, P.out};
        pg8::gemm_phase<EpiRes, SO, true, true>(lds, g, S, E);
    }
}

extern "C" void kernel_launch(void* const* d_in, const int* in_sizes, int n_in, void* d_out, int out_size, void* d_ws, size_t ws_size, hipStream_t stream) {
    static int grid = 0;
    if (grid == 0) {
        if (n_in != 29 || out_size != OUT_TOTAL || ws_size < WS_END) { fprintf(stderr, "kernel_launch: unexpected shapes (n_in %d out %d ws %zu)\n", n_in, out_size, ws_size); grid = -1; return; }
        int dev = 0, cus = 0, per_cu = 0;
        hipGetDevice(&dev); hipDeviceGetAttribute(&cus, hipDeviceAttributeMultiprocessorCount, dev);
        if (hipFuncSetAttribute((const void*)hybrid_fwd, hipFuncAttributeMaxDynamicSharedMemorySize, LDS_BYTES) != hipSuccess) { fprintf(stderr, "kernel_launch: hipFuncSetAttribute failed\n"); grid = -1; return; }
        if (hipOccupancyMaxActiveBlocksPerMultiprocessor(&per_cu, (const void*)hybrid_fwd, 512, LDS_BYTES) != hipSuccess || per_cu < 1) { fprintf(stderr, "kernel_launch: occupancy query says %d\n", per_cu); per_cu = 1; }
        (void)hipGetLastError();
        grid = cus;
    }
    if (grid < 0) return;
    Params p{};
    for (int i = 0; i < 29; ++i) p.in[i] = (const float*)d_in[i];
    p.out = (float*)d_out; p.ws = (unsigned char*)d_ws;
    if (hipMemsetAsync((unsigned char*)d_ws + WS_BAR, 0, 16384, stream) != hipSuccess) { fprintf(stderr, "kernel_launch: memset of the barrier words failed\n"); return; }
    void* args[] = {&p};
    const hipError_t e = hipLaunchCooperativeKernel((const void*)hybrid_fwd, dim3(grid), dim3(512), args, LDS_BYTES, stream);
    if (e != hipSuccess) fprintf(stderr, "kernel_launch: cooperative launch failed: %s (grid %d)\n", hipGetErrorString(e), grid);
}
```

```cpp
#include <hip/hip_runtime.h>
#include <hip/hip_cooperative_groups.h>
#include <cstdio>
#include <cstdint>
namespace cg = cooperative_groups;
namespace pg8 {
#define PG8_LAS __attribute__((address_space(3)))
typedef unsigned short bf16_t;
typedef short bf16x8 __attribute__((ext_vector_type(8)));
typedef float f32x4 __attribute__((ext_vector_type(4)));
typedef unsigned u32x4 __attribute__((ext_vector_type(4)));
constexpr int BM = 256, BK = 64, HALF = 128, HTB = HALF * BK * 2  , STAGE_BYTES = 8 * HTB, NXCD = 8, WGM = 8;

__host__ __device__ __forceinline__ int lds_byte(int r, int c) { const int st = (r >> 4) * 2 + (c >> 5), rr = r & 15, cc = c & 31, ob = rr * 64 + cc * 2; return st * 1024 + (ob ^ (((ob >> 9) & 1) << 5)); }
__host__ __device__ __forceinline__ void stage_rc(int b, int& R, int& C) { const int st = b / 1024, sb = b % 1024, swz = sb ^ (((sb >> 9) & 1) << 5); R = (st >> 1) * 16 + swz / 64; C = (st & 1) * 32 + (swz % 64) / 2; }
__host__ __device__ __forceinline__ int perm32(int rho) { const int n = rho >> 4, i = rho & 15; return 8 * (i >> 2) + 4 * n + (i & 3); }

struct Unit { int pm, pn; };
struct Gemm { const bf16_t* A; const bf16_t* Bt; int M, N, K; };

struct StaticOrder {
    int nM, nN, nwg, G, c;
    __host__ __device__ void init(int M, int N, int G_, int c_) { nM = M / BM; nN = N / BM; nwg = nM * nN; G = G_; c = c_; }
    __host__ __device__ bool next(int i, Unit& u) const {
        const long L = (long)i * G + c; if (L >= nwg) return false;
        int wgid = (int)L; { const int q = nwg / NXCD, r = nwg % NXCD, xcd = wgid % NXCD, off = wgid / NXCD; wgid = (xcd < r ? xcd * (q + 1) : r * (q + 1) + (xcd - r) * q) + off; }
        const int nig = WGM * nN, gid = wgid / nig, fm = gid * WGM, gsz = (nM - fm) < WGM ? (nM - fm) : WGM;
        u.pm = fm + ((wgid % nig) % gsz); u.pn = (wgid % nig) / gsz; return true;
    }
    __device__ __forceinline__ void a_ready(const Unit&) const {}
    __device__ __forceinline__ void done(const Unit&) const {}
};
__device__ __forceinline__ unsigned cvt_pk_bf16(float lo, float hi) { unsigned r; asm volatile("v_cvt_pk_bf16_f32 %0, %1, %2" : "=v"(r) : "v"(lo), "v"(hi)); return r; }
template <class Epi, class Sched, bool ALIGN_EPI = false, bool SP2 = false>
__device__ __forceinline__ void gemm_phase(PG8_LAS unsigned char* lds, const Gemm g, const Sched& S, const Epi& E) {
    const int tid = threadIdx.x, wid = __builtin_amdgcn_readfirstlane(tid >> 6), lane = tid & 63, wr = wid >> 2, wc = wid & 3, fr = lane & 15, fq = lane >> 4;
    const int K = g.K, nt = K / BK;
    unsigned voffA[2], voffB[2];
#pragma unroll
    for (int i = 0; i < 2; ++i) { int R, C; stage_rc(tid * 16 + i * 8192, R, C); const int Rb = Epi::PERM ? ((R & ~31) + perm32(R & 31)) : R;
        voffA[i] = (unsigned)(R * K + C) * 2u; voffB[i] = (unsigned)(Rb * K + C) * 2u; }
    const size_t kstep = (size_t)(BK * 2);
    const size_t hstep = (size_t)HALF * K * 2;
    const size_t tstep = 2 * hstep;
    const unsigned ldsw = (unsigned)wid * 1024u;
    const int aoff = lds_byte(wr * 64 + fr, fq * 8), boff = lds_byte(wc * 32 + fr, fq * 8);
#define PG8_SA(b, h) (((b) * 2 + (h)) * HTB)
#define PG8_SB(b, h) ((4 + (b) * 2 + (h)) * HTB)
#define PG8_STAGE(bufoff, gbase, voff) do { _Pragma("unroll") for (int _i = 0; _i < 2; ++_i) \
        __builtin_amdgcn_global_load_lds((const unsigned*)((const char*)(gbase) + (voff)[_i]), (PG8_LAS unsigned*)(lds + (bufoff) + ldsw + _i * 8192), 16, 0, 0); } while (0)
#define PG8_LDA(dst, b, h) do { _Pragma("unroll") for (int m = 0; m < 4; ++m) _Pragma("unroll") for (int k = 0; k < 2; ++k) dst[m][k] = *(const PG8_LAS bf16x8*)(lds + PG8_SA(b, h) + aoff + m * 2048 + k * 1024); } while (0)
#define PG8_LDB(dst, b, h) do { _Pragma("unroll") for (int n = 0; n < 2; ++n) _Pragma("unroll") for (int k = 0; k < 2; ++k) dst[n][k] = *(const PG8_LAS bf16x8*)(lds + PG8_SB(b, h) + boff + n * 2048 + k * 1024); } while (0)
#define PG8_MMA(ai, bj, At, Bt) do { __builtin_amdgcn_s_setprio(1); _Pragma("unroll") for (int m = 0; m < 4; ++m) _Pragma("unroll") for (int n = 0; n < 2; ++n) _Pragma("unroll") for (int k = 0; k < 2; ++k) \
        acc[ai][bj][m][n] = __builtin_amdgcn_mfma_f32_16x16x32_bf16(Bt[n][k], At[m][k], acc[ai][bj][m][n], 0, 0, 0); __builtin_amdgcn_s_setprio(0); } while (0)
#define PG8_WAIT_V(n) asm volatile("s_waitcnt vmcnt(" #n ")" ::: "memory")
#define PG8_WAIT_L(n) asm volatile("s_waitcnt lgkmcnt(" #n ")" ::: "memory")
#define PG8_BAR __builtin_amdgcn_s_barrier()
#define PG8_SCHED __builtin_amdgcn_sched_barrier(0)
    Unit cur, nxt; int ui = 0;
    if (!S.next(0, cur)) return;
    f32x4 acc[2][2][4][2];
#pragma unroll
    for (int a = 0; a < 2; ++a)
#pragma unroll
        for (int b = 0; b < 2; ++b)
#pragma unroll
            for (int m = 0; m < 4; ++m)
#pragma unroll
                for (int n = 0; n < 2; ++n) acc[a][b][m][n] = (f32x4){0.f, 0.f, 0.f, 0.f};
    bf16x8 At[4][2], B0[2][2], B1[2][2];
    const char* cA = (const char*)g.A + (size_t)cur.pm * tstep; const char* cB = (const char*)g.Bt + (size_t)cur.pn * tstep;
    S.a_ready(cur);
    if constexpr (SP2) {
        PG8_STAGE(PG8_SB(0, 0), cB, voffB); PG8_STAGE(PG8_SB(0, 1), cB + hstep, voffB); PG8_STAGE(PG8_SA(0, 0), cA, voffA); PG8_STAGE(PG8_SA(0, 1), cA + hstep, voffA);
        if (wr == 1) PG8_BAR;
        PG8_WAIT_V(2); PG8_BAR;
        PG8_STAGE(PG8_SB(1, 0), cB + kstep, voffB); PG8_STAGE(PG8_SA(1, 0), cA + kstep, voffA); PG8_STAGE(PG8_SB(1, 1), cB + hstep + kstep, voffB);
        PG8_WAIT_V(6); PG8_BAR;
    } else {
        PG8_STAGE(PG8_SB(0, 0), cB, voffB); PG8_STAGE(PG8_SA(0, 0), cA, voffA); PG8_STAGE(PG8_SB(0, 1), cB + hstep, voffB); PG8_STAGE(PG8_SA(0, 1), cA + hstep, voffA);
        if (wr == 1) PG8_BAR;
        PG8_WAIT_V(4); PG8_BAR;
        PG8_STAGE(PG8_SB(1, 0), cB + kstep, voffB); PG8_STAGE(PG8_SA(1, 0), cA + kstep, voffA); PG8_STAGE(PG8_SB(1, 1), cB + hstep + kstep, voffB);
        PG8_WAIT_V(6); PG8_BAR;
    }
    for (;;) {
        const bool has_next = S.next(ui + 1, nxt);
        const char* nA = has_next ? (const char*)g.A + (size_t)nxt.pm * tstep : cA; const char* nB = has_next ? (const char*)g.Bt + (size_t)nxt.pn * tstep : cB;
        for (int t = 0; t < nt; t += 2) {
            const bool last = (t == nt - 2);
            const char* a1 = cA + (size_t)(t + 1) * kstep;
            const char* a2 = last ? nA : cA + (size_t)(t + 2) * kstep; const char* b2 = last ? nB : cB + (size_t)(t + 2) * kstep;
            const char* a3 = a2 + kstep; const char* b3 = b2 + kstep;
            if (last && has_next) S.a_ready(nxt);
            if constexpr (SP2) {
            PG8_LDB(B0, 0, 0); PG8_LDB(B1, 0, 1); PG8_SCHED; PG8_LDA(At, 0, 0); PG8_STAGE(PG8_SA(1, 1), a1 + hstep, voffA);
            PG8_WAIT_V(8); PG8_WAIT_L(0); PG8_BAR; PG8_MMA(0, 0, At, B0); PG8_MMA(0, 1, At, B1); PG8_BAR; PG8_SCHED;
            PG8_LDA(At, 0, 1); PG8_STAGE(PG8_SB(0, 0), b2, voffB); PG8_STAGE(PG8_SB(0, 1), b2 + hstep, voffB); PG8_STAGE(PG8_SA(0, 0), a2, voffA);
            PG8_WAIT_V(8); PG8_WAIT_L(0); PG8_BAR; PG8_MMA(1, 0, At, B0); PG8_MMA(1, 1, At, B1); PG8_BAR; PG8_SCHED;
            PG8_LDB(B0, 1, 0); PG8_LDB(B1, 1, 1); PG8_SCHED; PG8_LDA(At, 1, 0); PG8_STAGE(PG8_SA(0, 1), a2 + hstep, voffA);
            PG8_WAIT_V(8); PG8_WAIT_L(0); PG8_BAR; PG8_MMA(0, 0, At, B0); PG8_MMA(0, 1, At, B1); PG8_BAR; PG8_SCHED;
            PG8_LDA(At, 1, 1); PG8_STAGE(PG8_SB(1, 0), b3, voffB); PG8_STAGE(PG8_SB(1, 1), b3 + hstep, voffB); PG8_STAGE(PG8_SA(1, 0), a3, voffA);
            PG8_WAIT_V(8); PG8_WAIT_L(0); PG8_BAR; PG8_MMA(1, 0, At, B0); PG8_MMA(1, 1, At, B1); PG8_BAR; PG8_SCHED;
            } else {
            PG8_LDB(B0, 0, 0); PG8_SCHED; PG8_LDA(At, 0, 0); PG8_STAGE(PG8_SA(1, 1), a1 + hstep, voffA);
            PG8_WAIT_L(8); PG8_BAR; PG8_WAIT_L(0); PG8_MMA(0, 0, At, B0); PG8_BAR; PG8_SCHED;
            PG8_LDB(B1, 0, 1); PG8_STAGE(PG8_SB(0, 0), b2, voffB);
            PG8_BAR; PG8_WAIT_L(0); PG8_MMA(0, 1, At, B1); PG8_BAR;
            PG8_LDA(At, 0, 1); PG8_STAGE(PG8_SA(0, 0), a2, voffA);
            PG8_BAR; PG8_WAIT_L(0); PG8_MMA(1, 0, At, B0); PG8_BAR; PG8_SCHED;
            PG8_STAGE(PG8_SB(0, 1), b2 + hstep, voffB);
            PG8_WAIT_V(6); PG8_BAR; PG8_MMA(1, 1, At, B1); PG8_BAR;
            PG8_LDB(B0, 1, 0); PG8_SCHED; PG8_LDA(At, 1, 0); PG8_STAGE(PG8_SA(0, 1), a2 + hstep, voffA);
            PG8_WAIT_L(8); PG8_BAR; PG8_WAIT_L(0); PG8_MMA(0, 0, At, B0); PG8_BAR; PG8_SCHED;
            PG8_LDB(B1, 1, 1); PG8_STAGE(PG8_SB(1, 0), b3, voffB);
            PG8_BAR; PG8_WAIT_L(0); PG8_MMA(0, 1, At, B1); PG8_BAR;
            PG8_LDA(At, 1, 1); PG8_STAGE(PG8_SA(1, 0), a3, voffA);
            PG8_BAR; PG8_WAIT_L(0); PG8_MMA(1, 0, At, B0); PG8_BAR; PG8_SCHED;
            PG8_STAGE(PG8_SB(1, 1), b3 + hstep, voffB);
            PG8_WAIT_V(6); PG8_BAR; PG8_MMA(1, 1, At, B1); PG8_BAR;
            }
        }
        if constexpr (ALIGN_EPI) { if (wr == 0) PG8_BAR; }
        if constexpr (!Epi::AFTER_DRAIN) { E(acc, cur, wr, wc, fr, fq); S.done(cur); }
        if (!has_next) break;
#pragma unroll
        for (int a = 0; a < 2; ++a)
#pragma unroll
            for (int b = 0; b < 2; ++b)
#pragma unroll
                for (int m = 0; m < 4; ++m)
#pragma unroll
                    for (int n = 0; n < 2; ++n) acc[a][b][m][n] = (f32x4){0.f, 0.f, 0.f, 0.f};
        cur = nxt; cA = nA; cB = nB; ++ui;
        if constexpr (ALIGN_EPI) { if (wr == 1) PG8_BAR; }
    }
    PG8_WAIT_V(0);
    if constexpr (!ALIGN_EPI) { if (wr == 0) PG8_BAR; }
    PG8_BAR;
    if constexpr (Epi::AFTER_DRAIN) { E.fused(acc, cur, wr, wc, fr, fq, lds, wid, lane); S.done(cur); }
#undef PG8_SA
#undef PG8_SB
#undef PG8_STAGE
#undef PG8_LDA
#undef PG8_LDB
#undef PG8_MMA
#undef PG8_WAIT_V
#undef PG8_WAIT_L
#undef PG8_BAR
#undef PG8_SCHED
}
}

#define LAS __attribute__((address_space(3)))
typedef unsigned short bf16;
typedef unsigned v4u __attribute__((ext_vector_type(4)));
typedef float f32x4 __attribute__((ext_vector_type(4)));
typedef short bf16x8 __attribute__((ext_vector_type(8)));
__device__ __forceinline__ f32x4 mfma16k(const bf16x8 a, const bf16x8 b, const f32x4 c) { const f32x4 d = __builtin_amdgcn_mfma_f32_16x16x32_bf16(a, b, c, 0, 0, 0); asm volatile("" :: "v"(a), "v"(b)); return d; }
#define MFMA16(a, b, c) mfma16k(a, b, c)
#define LDS_WAIT() asm volatile("s_waitcnt lgkmcnt(0)" ::: "memory")
__device__ __forceinline__ f32x4 zacc() { f32x4 z = {0.f, 0.f, 0.f, 0.f}; asm volatile("" : "+v"(z)); return z; }

constexpr int MP = 16384, MS = 512, MT = MP + MS;
constexpr int LDP = 2560;
constexpr size_t MiB = 1u << 20;
constexpr size_t WS_W1T = 0, WS_WGT = 6 * MiB, WS_W3T = 7 * MiB, WS_W4T = 9 * MiB, WS_W6T = 14 * MiB;
constexpr size_t WS_ROPE = 16 * MiB, WS_TAB = 19 * MiB, WS_ALOW = 20 * MiB, WS_LOC = 22 * MiB;
constexpr size_t WS_XN = 26 * MiB;
constexpr size_t WS_Z = WS_XN, WS_QD = WS_XN + 16 * MiB + 512 * 1024, WS_KDEC = WS_QD + 8 * MiB + 256 * 1024;
constexpr size_t WS_PROJ = 59 * MiB;
constexpr size_t WS_UT = 142 * MiB, WS_ST = 190 * MiB, WS_MIX = 214 * MiB, WS_XIN = 248 * MiB, WS_BAR = 252 * MiB, WS_END = 253 * MiB;
constexpr size_t WS_Q = 142 * MiB, WS_GATE = 175 * MiB, WS_KV = 208 * MiB, WS_VTG = 217 * MiB;
constexpr size_t TAB_LAMB = 0, TAB_LAMT = 16384, TAB_BB = 32768, TAB_CMT = 32768 + 262144, TAB_GD = TAB_CMT + 131072, TAB_BBF = 234 * MiB, TAB_SS = 851968;
constexpr int OFF_YS = 16777216, OFF_S5RE_P = 17301504, OFF_S5IM_P = 17305600, OFF_GLA_P = 17309696, OFF_SWK_P = 17375232, OFF_SWV_P = 17408000,
              OFF_S5RE_S = 17440768, OFF_S5IM_S = 17702912, OFF_GLA_S = 17965056, OFF_SWK_S = 22159360, OFF_SWV_S = 24256512, OUT_TOTAL = 26353664;
constexpr int LDS_BYTES = 147456;
constexpr float EPS = 1e-6f;

#ifndef REP_MASK
#define REP_MASK 0
#endif
#ifndef EXTRA_SYNCS
#define EXTRA_SYNCS 0
#endif
struct Params { const float* in[29]; float* out; unsigned char* ws; };
constexpr int PTAB_OFF = LDS_BYTES - 512;
__device__ __forceinline__ LAS unsigned char* lds0() { extern __shared__ __attribute__((aligned(16))) unsigned char lds_dyn_[]; return (LAS unsigned char*)lds_dyn_; }
__device__ __forceinline__ const float* inp_ptr(int k) { const unsigned long long v = ((const LAS unsigned long long*)(lds0() + PTAB_OFF))[k];
    const unsigned lo = __builtin_amdgcn_readfirstlane((unsigned)v), hi = __builtin_amdgcn_readfirstlane((unsigned)(v >> 32)); return (const float*)(((unsigned long long)hi << 32) | lo); }
#define INP(k) inp_ptr(k)

__device__ __forceinline__ float bf2f(unsigned u) { return __builtin_bit_cast(float, u << 16); }
__device__ __forceinline__ unsigned f2bf(float f) { unsigned u = __builtin_bit_cast(unsigned, f); return (u + 0x7fffu + ((u >> 16) & 1u)) >> 16; }
typedef __bf16 bf16x2_t __attribute__((ext_vector_type(2)));
typedef float f32x2_t __attribute__((ext_vector_type(2)));
__device__ __forceinline__ unsigned pk2(float lo, float hi) { return f2bf(lo) | (f2bf(hi) << 16); }
__device__ __forceinline__ float wave_sum(float v) {
#pragma unroll
    for (int o = 1; o < 64; o <<= 1) v += __shfl_xor(v, o);
    return v;
}
__device__ __forceinline__ float wave_max(float v) {
#pragma unroll
    for (int o = 1; o < 64; o <<= 1) v = fmaxf(v, __shfl_xor(v, o));
    return v;
}
__device__ __forceinline__ float sigm(float x) { return __builtin_amdgcn_rcpf(1.f + __expf(-x)); }
__device__ __forceinline__ float silu(float x) { return x * sigm(x); }
__device__ __forceinline__ float gelu_tanh(float y) { const float a = 0.7978845608028654f * (y + 0.044715f * y * y * y); const float th = 1.f - 2.f * __builtin_amdgcn_rcpf(__expf(2.f * a) + 1.f); return 0.5f * y * (1.f + th); }
#define UNPACK8(W_, F_) do { F_[0] = bf2f((W_).x & 0xffffu); F_[1] = bf2f((W_).x >> 16); F_[2] = bf2f((W_).y & 0xffffu); F_[3] = bf2f((W_).y >> 16); \
                           F_[4] = bf2f((W_).z & 0xffffu); F_[5] = bf2f((W_).z >> 16); F_[6] = bf2f((W_).w & 0xffffu); F_[7] = bf2f((W_).w >> 16); } while (0)
#define PACK8(F_) ((v4u){pk2(F_[0], F_[1]), pk2(F_[2], F_[3]), pk2(F_[4], F_[5]), pk2(F_[6], F_[7])})

__device__ __forceinline__ void dsincos(double a, double& s, double& c) {
    const double t = a * 0.15915494309189535; const double q = rint(t * 4.0); const double r = (t - q * 0.25) * 6.283185307179586; const double r2 = r * r;
    const double sp = r * (1.0 + r2 * (-1.0 / 6 + r2 * (1.0 / 120 + r2 * (-1.0 / 5040 + r2 * (1.0 / 362880 + r2 * (-1.0 / 39916800 + r2 * (1.0 / 6227020800.0)))))));
    const double cp = 1.0 + r2 * (-0.5 + r2 * (1.0 / 24 + r2 * (-1.0 / 720 + r2 * (1.0 / 40320 + r2 * (-1.0 / 3628800 + r2 * (1.0 / 479001600 + r2 * (-1.0 / 87178291200.0)))))));
    const int qi = ((int)q) & 3;
    s = (qi == 0) ? sp : (qi == 1) ? cp : (qi == 2) ? -sp : -cp;
    c = (qi == 0) ? cp : (qi == 1) ? -sp : (qi == 2) ? -cp : sp;
}

#define RLX_AGENT __ATOMIC_RELAXED, __HIP_MEMORY_SCOPE_AGENT
#define XB_TMO      128
#define XB_XCNT(j)  (256  + 64 * (j))
#define XB_XSUB(j)  (1280 + 64 * (j))
#define XB_XGEN(j)  (2304 + 64 * (j))
#define XB_TOP      3328
#define XB_TOPGEN   3392
#define XCD_BAR_WORDS 3456
#define XB_SPIN_CAP (1u << 18)

__device__ __forceinline__ unsigned xb_ld(unsigned* p)              { return __hip_atomic_load(p, __ATOMIC_RELAXED, __HIP_MEMORY_SCOPE_AGENT); }
__device__ __forceinline__ unsigned xb_add(unsigned* p, unsigned v) { return __hip_atomic_fetch_add(p, v, __ATOMIC_RELAXED, __HIP_MEMORY_SCOPE_AGENT); }
__device__ __forceinline__ unsigned xb_xcc_id() { return (unsigned)__builtin_amdgcn_s_getreg((3 << 11) | 20) & 0xFu; }
#define XB_SPIN(cond, bar) do { unsigned _sp = 0; while (cond) { __builtin_amdgcn_s_sleep(1); \
    if ((++_sp & 255u) == 0u) { if (xb_ld(&(bar)[XB_TMO])) break; if (_sp > XB_SPIN_CAP) { atomicAdd(&(bar)[XB_TMO], 1u); break; } } } } while (0)

struct XcdBarrier {
    unsigned* bar; unsigned x;
    volatile LAS unsigned* st;
};

__device__ __forceinline__ XcdBarrier xcd_barrier_post(unsigned* bar, volatile LAS unsigned* st) {
    XcdBarrier b; b.bar = bar; b.x = xb_xcc_id(); b.st = st;
    if (threadIdx.x == 0) (void)xb_add(&bar[XB_XCNT(b.x)], 1u);
    return b;
}
__device__ __forceinline__ void xcd_barrier_complete(unsigned* bar, unsigned x, unsigned& nloc, unsigned& nx) {
    const unsigned G = gridDim.x * gridDim.y * gridDim.z;
    unsigned sum, cnt, mine, sp = 0u;
    for (;;) {
        sum = 0u; cnt = 0u; mine = 0u;
#pragma unroll
        for (unsigned j = 0; j < 16; ++j) { const unsigned c = xb_ld(&bar[XB_XCNT(j)]); sum += c; cnt += (c > 0u) ? 1u : 0u; mine = (j == x) ? c : mine; }
        if (sum == G) break;
        __builtin_amdgcn_s_sleep(1);
        if ((++sp & 255u) == 0u) { if (xb_ld(&bar[XB_TMO])) break; if (sp > XB_SPIN_CAP) { atomicAdd(&bar[XB_TMO], 1u); break; } }
    }
    nloc = mine > 0u ? mine : 1u; nx = cnt > 0u ? cnt : 1u;
}

__device__ __forceinline__ void xcd_barrier(const XcdBarrier& b) {
    asm volatile("s_waitcnt vmcnt(0)" ::: "memory");
    __syncthreads();
    if (threadIdx.x == 0) {
        unsigned* bar = b.bar;
        __builtin_amdgcn_s_waitcnt(0);
        unsigned nloc = b.st[0], nx = b.st[1];
        if (nloc == 0u) { xcd_barrier_complete(bar, b.x, nloc, nx); b.st[0] = nloc; b.st[1] = nx; }
        const unsigned old = xb_add(&bar[XB_XSUB(b.x)], 1u);
        const unsigned gen = old / nloc;
        if (old + 1u == (gen + 1u) * nloc) {
            __builtin_amdgcn_fence(__ATOMIC_RELEASE, "agent");
            asm volatile("s_waitcnt vmcnt(0)" ::: "memory");
            const unsigned og = xb_add(&bar[XB_TOP], 1u);
            const unsigned tg = og / nx;
            if (og + 1u == (tg + 1u) * nx) xb_add(&bar[XB_TOPGEN], 1u);
            else XB_SPIN(xb_ld(&bar[XB_TOPGEN]) == tg, bar);
            __builtin_amdgcn_fence(__ATOMIC_ACQUIRE, "agent");
            xb_add(&bar[XB_XGEN(b.x)], 1u);
            asm volatile("s_waitcnt vmcnt(0)" ::: "memory");
        } else {
            XB_SPIN(xb_ld(&bar[XB_XGEN(b.x)]) == gen, bar);
            __builtin_amdgcn_fence(__ATOMIC_ACQUIRE, "agent");
            asm volatile("s_waitcnt vmcnt(0)" ::: "memory");
        }
    }
    __syncthreads();
}

__device__ __forceinline__ int map_w1(int p) { return p < 2048 ? p : (p < 2560 ? p + 16 : (p < 2576 ? p - 512 : -1)); }
__device__ __forceinline__ int map_w4(int p) { if (p >= 1280) return p; const int pn = p >> 8, pp = p & 255; return (4 * pn + ((pp >> 5) & 3)) * 64 + 32 * (pp >> 7) + (pp & 31); }
template <int MODE> __device__ __forceinline__ void transpose_item(const float* W, int K, int N, int NP, bf16* WT, LAS float* scr, int item, int lane) {
    const int nblk = NP / 32, kb = item / nblk, nb = item % nblk, k0 = 64 * kb, n0 = 32 * nb;
    const int p = n0 + (lane & 31);
    const int src = MODE == 0 ? p : (MODE == 1 ? map_w1(p) : map_w4(p));
#pragma unroll 8
    for (int i = 0; i < 32; ++i) { const int kk = 2 * i + (lane >> 5); scr[kk * 33 + (lane & 31)] = src >= 0 ? W[(size_t)(k0 + kk) * N + src] : 0.f; }
    LDS_WAIT();
    const int c = lane & 7;
#pragma unroll
    for (int j = 0; j < 4; ++j) { const int n = (lane >> 3) + 8 * j; const LAS float* s = scr + (8 * c) * 33 + n;
        v4u o; o.x = pk2(s[0 * 33], s[1 * 33]); o.y = pk2(s[2 * 33], s[3 * 33]); o.z = pk2(s[4 * 33], s[5 * 33]); o.w = pk2(s[6 * 33], s[7 * 33]);
        *(v4u*)(WT + (size_t)(n0 + n) * K + k0 + 8 * c) = o; }
    LDS_WAIT();
}
__device__ __forceinline__ void rms_row(const float* xrow, const float* g, bf16* orow, int lane) {
    const f32x4* xr = (const f32x4*)xrow + lane; const f32x4* gr = (const f32x4*)g + lane;
    f32x4 v[4]; float s = 0.f;
#pragma unroll
    for (int j = 0; j < 4; ++j) { v[j] = xr[64 * j]; s += (v[j].x * v[j].x + v[j].y * v[j].y) + (v[j].z * v[j].z + v[j].w * v[j].w); }
    const float r = 1.f / sqrtf(wave_sum(s) * (1.f / 1024.f) + EPS);
    unsigned long long* o8 = (unsigned long long*)orow + lane;
#pragma unroll
    for (int j = 0; j < 4; ++j) { const f32x4 gg = gr[64 * j];
        o8[64 * j] = (unsigned long long)pk2(v[j].x * r * gg.x, v[j].y * r * gg.y) | ((unsigned long long)pk2(v[j].z * r * gg.z, v[j].w * r * gg.w) << 32); }
}

template <int PART> __device__ __forceinline__ void phase0(const Params& P, LAS unsigned char* lds, int tid, int lane, int wave, int wb0) {
    const int G = (int)gridDim.x - wb0, gw = ((int)blockIdx.x - wb0) * 8 + wave, NGW = G * 8;
    unsigned char* ws = P.ws;
    LAS float* scr = (LAS float*)(lds + wave * 16384);
    constexpr int I1 = 16 * 88, IG = 8 * 16, I3 = 16 * 32, I4 = 16 * 72, I6 = 16 * 32;
    if (PART == 0) {
        for (int it = gw; it < I1 + IG; it += NGW) {
            if (it < I1) transpose_item<1>(INP(8), 1024, 2576, 2816, (bf16*)(ws + WS_W1T), scr, it, lane);
            else transpose_item<0>(INP(17), 512, 512, 512, (bf16*)(ws + WS_WGT), scr, it - I1, lane);
        }
    } else {
        for (int it = gw; it < I3 + I4 + I6; it += NGW) {
            int r = it;
            if (r < I3) { transpose_item<0>(INP(22), 1024, 1024, 1024, (bf16*)(ws + WS_W3T), scr, r, lane); continue; } r -= I3;
            if (r < I4) { transpose_item<2>(INP(24), 1024, 2304, 2304, (bf16*)(ws + WS_W4T), scr, r, lane); continue; } r -= I4;
            transpose_item<0>(INP(28), 1024, 1024, 1024, (bf16*)(ws + WS_W6T), scr, r, lane);
        }
    }
    bf16* XN = (bf16*)(ws + WS_XN);
    if (PART == 0) for (int m = gw; m < MT; m += NGW) { const float* xr = m < MP ? INP(0) + (size_t)m * 1024 : INP(1) + (size_t)(m - MP) * 1024; rms_row(xr, INP(7), XN + (size_t)m * 1024, lane); }
    const int gt = ((int)blockIdx.x - wb0) * 512 + tid, NT = G * 512;
    if (PART == 0) for (int i = gt; i < 2048; i += NT) {
        const int g = i >> 6;
        const double lre = INP(9)[i], lim = INP(10)[i], dt = exp((double)INP(11)[g]);
        double s1, c1, s64, c64; dsincos(lim * dt, s1, c1); dsincos(lim * dt * 64.0, s64, c64);
        const double e1 = exp(lre * dt), e64 = exp(lre * dt * 64.0);
        const double lbr = e1 * c1, lbi = e1 * s1;
        ((float2*)(ws + WS_TAB + TAB_LAMB))[i] = make_float2((float)lbr, (float)lbi);
        ((float2*)(ws + WS_TAB + TAB_LAMT))[i] = make_float2((float)(e64 * c64), (float)(e64 * s64));
        const double den = lre * lre + lim * lim, nr = lbr - 1.0, ni = lbi;
        const double fr = (nr * lre + ni * lim) / den, fi = (ni * lre - nr * lim) / den;
        bf16* bbt = (bf16*)(ws + WS_TAB + TAB_BB) + (size_t)(g * 128 + (i & 63)) * 16;
        float* bbf = (float*)(ws + WS_TAB + TAB_BBF) + (size_t)i * 32;
#pragma unroll
        for (int c = 0; c < 16; ++c) { const double br = INP(12)[i * 16 + c], bi = INP(13)[i * 16 + c]; bbf[c] = (float)(fr * br - fi * bi); bbf[16 + c] = (float)(fr * bi + fi * br); bbt[c] = (bf16)f2bf((float)(fr * br - fi * bi)); bbt[64 * 16 + c] = (bf16)f2bf((float)(fr * bi + fi * br)); }
    }
    if (PART == 0) for (int i = gt; i < MT; i += NT) ((float*)(ws + WS_TAB + TAB_SS))[i] = 0.f;
    if (PART == 0) for (int i = gt; i < 65536; i += NT) { const int gc = i >> 7, k = i & 127; const float v = k < 64 ? INP(14)[gc * 64 + k] : -INP(15)[gc * 64 + k - 64]; ((bf16*)(ws + WS_TAB + TAB_CMT))[i] = (bf16)f2bf(v); }
    if (PART == 1) for (int i = gt; i < 8196 * 32; i += NT) { const int pos = i >> 5, j = i & 31; const double inv = exp(-(double)j * (9.210340371976184 / 32.0)); double s, c; dsincos((double)pos * inv, s, c);
        ((float2*)(ws + WS_ROPE))[i] = make_float2((float)c, (float)s); }
    if (PART == 1) for (int i = gt; i < 128 * 3968; i += NT) { const int seq = i / 3968, r = i % 3968;
        ((f32x4*)(P.out + OFF_SWK_S))[seq * 4096 + r] = ((const f32x4*)INP(5))[seq * 4096 + 128 + r];
        ((f32x4*)(P.out + OFF_SWV_S))[seq * 4096 + r] = ((const f32x4*)INP(6))[seq * 4096 + 128 + r]; }
}

struct EpiProj {
    static constexpr bool PERM = true, AFTER_DRAIN = false;
    bf16* O; float* alow;
    __device__ __forceinline__ void operator()(const f32x4 (&acc)[2][2][4][2], const pg8::Unit& u, int wr, int wc, int fr, int fq) const {
        const int row0 = u.pm * 256 + wr * 64 + fr;
        if (u.pn < 10) {
            const int col0 = u.pn * 256 + wc * 32 + 8 * fq;
#pragma unroll
            for (int ai = 0; ai < 2; ++ai)
#pragma unroll
                for (int m = 0; m < 4; ++m) { bf16* rowp = O + (size_t)(row0 + ai * 128 + m * 16) * LDP + col0;
#pragma unroll
                    for (int bj = 0; bj < 2; ++bj) { const f32x4 v0 = acc[ai][bj][m][0], v1 = acc[ai][bj][m][1];
                        v4u w; w.x = pk2(v0[0], v0[1]); w.y = pk2(v0[2], v0[3]); w.z = pk2(v1[0], v1[1]); w.w = pk2(v1[2], v1[3]);
                        *(v4u*)(rowp + bj * 128) = w; } }
        } else if (wc == 0 && fq < 2) {
#pragma unroll
            for (int ai = 0; ai < 2; ++ai)
#pragma unroll
                for (int m = 0; m < 4; ++m) { float* rowp = alow + (size_t)(row0 + ai * 128 + m * 16) * 16 + 8 * fq;
                    *(f32x4*)rowp = acc[ai][0][m][0]; *(f32x4*)(rowp + 4) = acc[ai][0][m][1]; }
        }
    }
};
struct EpiGlu {
    static constexpr bool PERM = true, AFTER_DRAIN = false;
    const bf16* Z; const bf16* PROJ; const float* bias; bf16* MIX;
    __device__ __forceinline__ void operator()(const f32x4 (&acc)[2][2][4][2], const pg8::Unit& u, int wr, int wc, int fr, int fq) const {
        const int row0 = u.pm * 256 + wr * 64 + fr, col0 = u.pn * 256 + wc * 32 + 8 * fq;
#pragma unroll
        for (int bj = 0; bj < 2; ++bj) { const int col = col0 + bj * 128;
            const f32x4 b0 = *(const f32x4*)(bias + col), b1 = *(const f32x4*)(bias + col + 4);
#pragma unroll
            for (int ai = 0; ai < 2; ++ai)
#pragma unroll
                for (int m = 0; m < 4; ++m) { const size_t row = (size_t)(row0 + ai * 128 + m * 16);
                    const v4u zw = *(const v4u*)(Z + row * 512 + col), gw = *(const v4u*)(PROJ + row * LDP + 512 + col);
                    float z[8], g[8], o[8]; UNPACK8(zw, z); UNPACK8(gw, g);
                    const f32x4 v0 = acc[ai][bj][m][0] + b0, v1 = acc[ai][bj][m][1] + b1;
#pragma unroll
                    for (int e = 0; e < 4; ++e) { o[e] = z[e] * sigm(v0[e]) * silu(g[e]); o[4 + e] = z[4 + e] * sigm(v1[e]) * silu(g[4 + e]); }
                    *(v4u*)(MIX + row * 1024 + col) = PACK8(o); } }
    }
};
struct EpiRes {
    static constexpr bool PERM = true, AFTER_DRAIN = false;
    const float* resA; const float* resB; float* O;
    __device__ __forceinline__ void operator()(const f32x4 (&acc)[2][2][4][2], const pg8::Unit& u, int wr, int wc, int fr, int fq) const {
        const int row0 = u.pm * 256 + wr * 64 + fr, col0 = u.pn * 256 + wc * 32 + 8 * fq;
#pragma unroll
        for (int ai = 0; ai < 2; ++ai)
#pragma unroll
            for (int m = 0; m < 4; ++m) { const int row = row0 + ai * 128 + m * 16;
                const float* rp = (row < MP ? resA + (size_t)row * 1024 : resB + (size_t)(row - MP) * 1024) + col0; float* op = O + (size_t)row * 1024 + col0;
#pragma unroll
                for (int bj = 0; bj < 2; ++bj) { const f32x4 r0 = *(const f32x4*)(rp + bj * 128), r1 = *(const f32x4*)(rp + bj * 128 + 4);
                    *(f32x4*)(op + bj * 128) = r0 + acc[ai][bj][m][0]; *(f32x4*)(op + bj * 128 + 4) = r1 + acc[ai][bj][m][1]; } }
    }
};
struct EpiResNorm {
    static constexpr bool PERM = true, AFTER_DRAIN = false;
    const float* resA; const float* resB; float* O; bf16* XN; const float* g; float* SS;
    __device__ __forceinline__ void operator()(const f32x4 (&acc)[2][2][4][2], const pg8::Unit& u, int wr, int wc, int fr, int fq) const {
        const int row0 = u.pm * 256 + wr * 64 + fr, col0 = u.pn * 256 + wc * 32 + 8 * fq;
        f32x4 gv[2][2];
#pragma unroll
        for (int bj = 0; bj < 2; ++bj) { gv[bj][0] = *(const f32x4*)(g + col0 + bj * 128); gv[bj][1] = *(const f32x4*)(g + col0 + bj * 128 + 4); }
#pragma unroll
        for (int ai = 0; ai < 2; ++ai)
#pragma unroll
            for (int m = 0; m < 4; ++m) { const int row = row0 + ai * 128 + m * 16;
                const float* rp = (row < MP ? resA + (size_t)row * 1024 : resB + (size_t)(row - MP) * 1024) + col0; float* op = O + (size_t)row * 1024 + col0;
                bf16* xp = XN + (size_t)row * 1024 + col0; float ss = 0.f;
#pragma unroll
                for (int bj = 0; bj < 2; ++bj) { const f32x4 r0 = *(const f32x4*)(rp + bj * 128), r1 = *(const f32x4*)(rp + bj * 128 + 4);
                    const f32x4 h0 = r0 + acc[ai][bj][m][0], h1 = r1 + acc[ai][bj][m][1];
                    *(f32x4*)(op + bj * 128) = h0; *(f32x4*)(op + bj * 128 + 4) = h1;
                    ss += (h0[0] * h0[0] + h0[1] * h0[1]) + (h0[2] * h0[2] + h0[3] * h0[3]) + (h1[0] * h1[0] + h1[1] * h1[1]) + (h1[2] * h1[2] + h1[3] * h1[3]);
                    const f32x4 x0 = h0 * gv[bj][0], x1 = h1 * gv[bj][1];
                    v4u w; w.x = pk2(x0[0], x0[1]); w.y = pk2(x0[2], x0[3]); w.z = pk2(x1[0], x1[1]); w.w = pk2(x1[2], x1[3]);
                    *(v4u*)(xp + bj * 128) = w; }
                ss += __shfl_xor(ss, 16); ss += __shfl_xor(ss, 32);
                if (fq == 0) atomicAdd(SS + row, ss); }
    }
};
struct EpiQKV {
    static constexpr bool PERM = true, AFTER_DRAIN = false;
    bf16* Q; bf16* KV; bf16* GT; const float* gq; const float* gk; const float2* rope; float* out; const float* SS;
    __device__ __forceinline__ void operator()(const f32x4 (&acc)[2][2][4][2], const pg8::Unit& u, int wr, int wc, int fr, int fq) const {
        const int row0 = u.pm * 256 + wr * 64 + fr;
        if (u.pn >= 5) {
            const int col0 = (u.pn - 5) * 256 + wc * 32 + 8 * fq;
#pragma unroll
            for (int ai = 0; ai < 2; ++ai)
#pragma unroll
                for (int m = 0; m < 4; ++m) { bf16* rowp = GT + (size_t)(row0 + ai * 128 + m * 16) * 1024 + col0;
                    const float rr = 1.f / sqrtf(SS[row0 + ai * 128 + m * 16] * (1.f / 1024.f) + EPS);
#pragma unroll
                    for (int bj = 0; bj < 2; ++bj) { const f32x4 v0 = acc[ai][bj][m][0] * rr, v1 = acc[ai][bj][m][1] * rr;
                        v4u w; w.x = pk2(v0[0], v0[1]); w.y = pk2(v0[2], v0[3]); w.z = pk2(v1[0], v1[1]); w.w = pk2(v1[2], v1[3]);
                        *(v4u*)(rowp + bj * 128) = w; } }
            return;
        }
        const int head = 4 * u.pn + wc;
        const bool isv = head >= 18;
        const float* gsrc = head < 16 ? gq : gk;
        f32x4 gw[2][2];
#pragma unroll
        for (int bj = 0; bj < 2; ++bj)
#pragma unroll
            for (int n = 0; n < 2; ++n) gw[bj][n] = *(const f32x4*)(gsrc + 32 * bj + 8 * fq + 4 * n);
#pragma unroll
        for (int ai = 0; ai < 2; ++ai)
#pragma unroll
            for (int m = 0; m < 4; ++m) {
                const int row = row0 + ai * 128 + m * 16;
                const int pos = row < MP ? (row & 8191) : 8192 + ((row - MP) & 3);
                const float rr = 1.f / sqrtf(SS[row] * (1.f / 1024.f) + EPS);
                f32x4 o[2][2];
                if (!isv) {
                    float ss = 0.f;
#pragma unroll
                    for (int bj = 0; bj < 2; ++bj)
#pragma unroll
                        for (int n = 0; n < 2; ++n) { const f32x4 a = acc[ai][bj][m][n]; ss += (a[0] * a[0] + a[1] * a[1]) + (a[2] * a[2] + a[3] * a[3]); }
                    ss += __shfl_xor(ss, 16); ss += __shfl_xor(ss, 32);
                    const float rs = rr / sqrtf(ss * (rr * rr) * (1.f / 64.f) + EPS);
#pragma unroll
                    for (int n = 0; n < 2; ++n) { const f32x4 x1 = acc[ai][0][m][n] * rs * gw[0][n], x2 = acc[ai][1][m][n] * rs * gw[1][n];
                        const float2* rp = rope + (size_t)pos * 32 + 8 * fq + 4 * n;
#pragma unroll
                        for (int e = 0; e < 4; ++e) { const float2 cs = rp[e]; o[0][n][e] = x1[e] * cs.x - x2[e] * cs.y; o[1][n][e] = x2[e] * cs.x + x1[e] * cs.y; } }
                } else {
#pragma unroll
                    for (int bj = 0; bj < 2; ++bj)
#pragma unroll
                        for (int n = 0; n < 2; ++n) o[bj][n] = acc[ai][bj][m][n] * rr;
                }
                if (head < 16) {
#pragma unroll
                    for (int bj = 0; bj < 2; ++bj) { const f32x4 v0 = o[bj][0] * 0.18033688011112042f, v1 = o[bj][1] * 0.18033688011112042f;
                        v4u w; w.x = pk2(v0[0], v0[1]); w.y = pk2(v0[2], v0[3]); w.z = pk2(v1[0], v1[1]); w.w = pk2(v1[2], v1[3]);
                        *(v4u*)(Q + (size_t)row * 1024 + head * 64 + 32 * bj + 8 * fq) = w; }
                } else {
                    const int kvi = head - 16, kvh = kvi & 1;
                    float* cdst = nullptr;
                    if (row < MP) { if (pos >= 8064) cdst = out + (kvi < 2 ? OFF_SWK_P : OFF_SWV_P) + (((row >> 13) * 128 + pos - 8064) * 2 + kvh) * 64; }
                    else { const int sq = (row - MP) >> 2, t = (row - MP) & 3; cdst = out + (kvi < 2 ? OFF_SWK_S : OFF_SWV_S) + ((sq * 128 + 124 + t) * 2 + kvh) * 64; }
#pragma unroll
                    for (int bj = 0; bj < 2; ++bj) { const f32x4 v0 = o[bj][0], v1 = o[bj][1];
                        v4u w; w.x = pk2(v0[0], v0[1]); w.y = pk2(v0[2], v0[3]); w.z = pk2(v1[0], v1[1]); w.w = pk2(v1[2], v1[3]);
                        *(v4u*)(KV + (size_t)row * 256 + kvi * 64 + 32 * bj + 8 * fq) = w;
                        if (cdst) { *(f32x4*)(cdst + 32 * bj + 8 * fq) = v0; *(f32x4*)(cdst + 32 * bj + 8 * fq + 4) = v1; } }
                }
            }
    }
};

__device__ __forceinline__ void s5_decode(int it, int& g, int& row0, int& T) {
    if (it < 8192) { g = it & 31; const int ch = (it >> 5) & 127, n = it >> 12; row0 = n * 8192 + ch * 64; T = 64; }
    else { const int j = it - 8192; g = j & 31; row0 = MP + (j >> 5) * 4; T = 4; }
}
__device__ __forceinline__ void s5_load_u(const bf16* PROJ, int it, int lane, bf16x8 (&ua)[4]) {
    int g, row0, T; s5_decode(it, g, row0, T);
    const int fr = lane & 15, fq = lane >> 4;
#pragma unroll
    for (int tile = 0; tile < 4; ++tile) { const int t = 16 * tile + fr; bf16x8 v = {0, 0, 0, 0, 0, 0, 0, 0};
        if (fq < 2 && t < T) v = *(const bf16x8*)(PROJ + (size_t)(row0 + t) * LDP + g * 16 + 8 * fq);
        ua[tile] = v; }
}
template <bool OUT> __device__ __forceinline__ void s5_item(const Params& P, int it, int lane, LAS float* BU, LAS bf16* XS, const bf16x8 (&ua)[4]) {
    unsigned char* ws = P.ws;
    int g, row0, T; s5_decode(it, g, row0, T);
    const bool prompt = it < 8192; const int seq = prompt ? (it >> 12) : ((it - 8192) >> 5); const bool lastc = prompt && (((it >> 5) & 127) == 127);
    const int slot = (it >> 5) * 2048 + g * 64 + lane;
    const int gp = g * 64 + lane, fr = lane & 15, fq = lane >> 4;
    const float2 lam = ((const float2*)(ws + WS_TAB + TAB_LAMB))[gp];
    bf16x8 bb[8];
#pragma unroll
    for (int jt = 0; jt < 8; ++jt) { bf16x8 v = {0, 0, 0, 0, 0, 0, 0, 0}; if (fq < 2) v = *(const bf16x8*)((const bf16*)(ws + WS_TAB + TAB_BB) + (size_t)(g * 128 + 16 * jt + fr) * 16 + 8 * fq); bb[jt] = v; }
    bf16x8 bfr[4], dg;
    if (OUT) {
        const bf16* cm = (const bf16*)(ws + WS_TAB + TAB_CMT) + (size_t)(g * 16 + fr) * 128 + 8 * fq;
#pragma unroll
        for (int s = 0; s < 4; ++s) bfr[s] = *(const bf16x8*)(cm + 32 * s);
        const short d16 = (short)f2bf(INP(16)[g * 16 + fr]);
#pragma unroll
        for (int j = 0; j < 8; ++j) dg[j] = (8 * fq + j == fr) ? d16 : (short)0;
    }
    float xr = 0.f, xi = 0.f;
    if (OUT) { if (prompt) { const float2 x0 = ((const float2*)(ws + WS_XIN))[slot]; xr = x0.x; xi = x0.y; } else { xr = INP(2)[(seq * 32 + g) * 64 + lane]; xi = INP(3)[(seq * 32 + g) * 64 + lane]; } }
    bf16* Z = (bf16*)(ws + WS_Z);
    const int ntile = (T + 15) >> 4;
#pragma unroll
    for (int tile = 0; tile < 4; ++tile) {
        if (tile < ntile) {
            f32x4 accs[8];
#pragma unroll
            for (int jt = 0; jt < 8; ++jt) { accs[jt] = MFMA16(ua[tile], bb[jt], zacc()); }
            __builtin_amdgcn_sched_barrier(0); asm volatile("s_nop 15\n\ts_nop 15" ::: "memory"); __builtin_amdgcn_sched_barrier(0);
#pragma unroll
            for (int jt = 0; jt < 8; ++jt)
#pragma unroll
                for (int r = 0; r < 4; ++r) BU[(4 * fq + r) * 130 + 16 * jt + fr] = accs[jt][r];
            LDS_WAIT();
            if (T == 64) {
#pragma unroll
                for (int t = 0; t < 16; ++t) { float br = BU[t * 130 + lane], bi = BU[t * 130 + 64 + lane];

                    const float nr = lam.x * xr - lam.y * xi + br, ni = lam.x * xi + lam.y * xr + bi; xr = nr; xi = ni;
                    if (OUT) { const unsigned pk = pk2(xr, xi); XS[t * 136 + lane] = (bf16)(pk & 0xffffu); XS[t * 136 + 64 + lane] = (bf16)(pk >> 16); } }
            } else {
#pragma unroll
                for (int t = 0; t < 4; ++t) { const float br = BU[t * 130 + lane], bi = BU[t * 130 + 64 + lane];
                    const float nr = lam.x * xr - lam.y * xi + br, ni = lam.x * xi + lam.y * xr + bi; xr = nr; xi = ni;
                    if (OUT) { const unsigned pk = pk2(xr, xi); XS[t * 136 + lane] = (bf16)(pk & 0xffffu); XS[t * 136 + 64 + lane] = (bf16)(pk >> 16); } }
            }
            if (OUT) {
                LDS_WAIT();
                f32x4 y = zacc();
#pragma unroll
                for (int s = 0; s < 4; ++s) { const bf16x8 a = *(const LAS bf16x8*)(XS + fr * 136 + 32 * s + 8 * fq); y = MFMA16(a, bfr[s], y); }
                y = MFMA16(ua[tile], dg, y);
#pragma unroll
                for (int r = 0; r < 4; ++r) { const int t = 16 * tile + 4 * fq + r; if (t < T) Z[(size_t)(row0 + t) * 512 + g * 16 + fr] = (bf16)f2bf(gelu_tanh(y[r])); }
            }
            LDS_WAIT();
        }
    }
    if (!OUT) { ((float2*)(ws + WS_LOC))[slot] = make_float2(xr, xi); return; }
    if (prompt) { if (lastc) { P.out[OFF_S5RE_P + (seq * 32 + g) * 64 + lane] = xr; P.out[OFF_S5IM_P + (seq * 32 + g) * 64 + lane] = xi; } }
    else { P.out[OFF_S5RE_S + (seq * 32 + g) * 64 + lane] = xr; P.out[OFF_S5IM_S + (seq * 32 + g) * 64 + lane] = xi; }
}
template <bool OUT> __device__ __forceinline__ void s5_loop(const Params& P, int nitems, int gw, int NGW, int lane, LAS unsigned char* wlds) {
    const bf16* PROJ = (const bf16*)(P.ws + WS_PROJ);
    LAS float* BU = (LAS float*)wlds; LAS bf16* XS = (LAS bf16*)(wlds + 8320);
    bf16x8 ua[4];
    for (int it = gw; it < nitems; it += NGW) {
        s5_load_u(PROJ, it, lane, ua);
        s5_item<OUT>(P, it, lane, BU, XS, ua);
    }
}

template <bool OUT> __device__ __forceinline__ void s5_item_old(const Params& P, int it, int lane, LAS bf16* XS) {
    unsigned char* ws = P.ws;
    const bf16* PROJ = (const bf16*)(ws + WS_PROJ);
    int g, row0, T, slot = 0, seq = 0; bool prompt = true, lastc = false;
    if (it < 8192) { g = it & 31; const int ch = (it >> 5) & 127, n = it >> 12; row0 = n * 8192 + ch * 64; T = 64; slot = ((n * 128 + ch) * 32 + g) * 64 + lane; lastc = (ch == 127); seq = n; }
    else { const int j = it - 8192; g = j & 31; seq = j >> 5; row0 = MP + seq * 4; T = 4; prompt = false; }
    const int gp = g * 64 + lane;
    const float2 lam = ((const float2*)(ws + WS_TAB + TAB_LAMB))[gp];
    float bre[16], bim[16];
    { const f32x4* bb = (const f32x4*)((const float*)(ws + WS_TAB + TAB_BBF) + (size_t)gp * 32);
#pragma unroll
      for (int q = 0; q < 4; ++q) { const f32x4 a = bb[q], b = bb[4 + q];
#pragma unroll
          for (int e = 0; e < 4; ++e) { bre[4 * q + e] = a[e]; bim[4 * q + e] = b[e]; } } }
    float xr = 0.f, xi = 0.f;
    if (OUT) { if (prompt) { const float2 x0 = ((const float2*)(ws + WS_XIN))[slot]; xr = x0.x; xi = x0.y; } else { xr = INP(2)[(seq * 32 + g) * 64 + lane]; xi = INP(3)[(seq * 32 + g) * 64 + lane]; } }
    const bf16* up = PROJ + (size_t)row0 * LDP + g * 16;
#pragma unroll 4
    for (int t = 0; t < T; ++t) {
        const v4u w0 = *(const v4u*)(up + (size_t)t * LDP), w1 = *(const v4u*)(up + (size_t)t * LDP + 8);
        float u[16]; UNPACK8(w0, u); { float* u8 = u + 8; UNPACK8(w1, u8); }
        float br = 0.f, bi = 0.f;
#pragma unroll
        for (int c = 0; c < 16; ++c) { br += bre[c] * u[c]; bi += bim[c] * u[c]; }
        const float nr = lam.x * xr - lam.y * xi + br, ni = lam.x * xi + lam.y * xr + bi; xr = nr; xi = ni;
        if (OUT) { XS[t * 136 + lane] = (bf16)f2bf(xr); XS[t * 136 + 64 + lane] = (bf16)f2bf(xi); }
    }
    if (!OUT) { ((float2*)(ws + WS_LOC))[slot] = make_float2(xr, xi); return; }
    if (prompt) { if (lastc) { P.out[OFF_S5RE_P + (seq * 32 + g) * 64 + lane] = xr; P.out[OFF_S5IM_P + (seq * 32 + g) * 64 + lane] = xi; } }
    else { P.out[OFF_S5RE_S + (seq * 32 + g) * 64 + lane] = xr; P.out[OFF_S5IM_S + (seq * 32 + g) * 64 + lane] = xi; }
    LDS_WAIT();
    const int fr = lane & 15, fq = lane >> 4;
    const bf16* cm = (const bf16*)(ws + WS_TAB + TAB_CMT) + (size_t)(g * 16 + fr) * 128 + 8 * fq;
    bf16x8 bfr[4];
#pragma unroll
    for (int s = 0; s < 4; ++s) bfr[s] = *(const bf16x8*)(cm + 32 * s);
    const float dv = INP(16)[g * 16 + fr];
    bf16* Z = (bf16*)(ws + WS_Z);
    const int ntile = (T + 15) >> 4;
    for (int rt = 0; rt < ntile; ++rt) {
        f32x4 acc = zacc();
#pragma unroll
        for (int s = 0; s < 4; ++s) { const bf16x8 a = *(const LAS bf16x8*)(XS + (16 * rt + fr) * 136 + 32 * s + 8 * fq); acc = MFMA16(a, bfr[s], acc); }
#pragma unroll
        for (int r = 0; r < 4; ++r) { const int t = 16 * rt + 4 * fq + r;
            if (t < T) { const size_t row = (size_t)(row0 + t); const float u = bf2f(PROJ[row * LDP + g * 16 + fr]);
                Z[row * 512 + g * 16 + fr] = (bf16)f2bf(gelu_tanh(acc[r] + dv * u)); } }
    }
    LDS_WAIT();
}


__device__ __forceinline__ void gla_decode(int item, int& h, int& row0, int& T) {
    if (item < 1024) { h = item & 3; const int ch = (item >> 2) & 127, n = item >> 9; row0 = n * 8192 + ch * 64; T = 64; }
    else { const int j = item - 1024; h = j & 3; row0 = MP + (j >> 2) * 4; T = 4; }
}
__device__ __forceinline__ void gla_passA(const Params& P, int item, LAS unsigned char* lds, int tid, int lane, int wave) {
    unsigned char* ws = P.ws;
    const bf16* PROJ = (const bf16*)(ws + WS_PROJ);
    int h, row0, T; gla_decode(item, h, row0, T);
    LAS float* LA = (LAS float*)lds; LAS bf16* KT = (LAS bf16*)(lds + 16384); LAS bf16* VT = (LAS bf16*)(lds + 25600);
    const int t = tid >> 3, kg = tid & 7, kd0 = kg * 8, v0 = kg * 16;
    const bool act = t < T;
    float la[8];
    v4u qv = {0, 0, 0, 0}, kv = {0, 0, 0, 0}, vv0 = {0, 0, 0, 0}, vv1 = {0, 0, 0, 0};
    if (act) {
        const size_t row = (size_t)(row0 + t);
        qv = *(const v4u*)(PROJ + row * LDP + 1024 + h * 64 + kd0); kv = *(const v4u*)(PROJ + row * LDP + 1280 + h * 64 + kd0);
        vv0 = *(const v4u*)(PROJ + row * LDP + 1536 + h * 128 + v0); vv1 = *(const v4u*)(PROJ + row * LDP + 1536 + h * 128 + v0 + 8);
        const f32x4* ap = (const f32x4*)((const float*)(ws + WS_ALOW) + row * 16);
        float a[16];
#pragma unroll
        for (int q = 0; q < 4; ++q) { const f32x4 x = ap[q]; a[4 * q] = x[0]; a[4 * q + 1] = x[1]; a[4 * q + 2] = x[2]; a[4 * q + 3] = x[3]; }
        const f32x4 bg0 = *(const f32x4*)(INP(20) + h * 64 + kd0), bg1 = *(const f32x4*)(INP(20) + h * 64 + kd0 + 4);
        float lg[8] = {bg0[0], bg0[1], bg0[2], bg0[3], bg1[0], bg1[1], bg1[2], bg1[3]};
#pragma unroll
        for (int r = 0; r < 16; ++r) { const f32x4 w0 = *(const f32x4*)(INP(19) + r * 256 + h * 64 + kd0), w1 = *(const f32x4*)(INP(19) + r * 256 + h * 64 + kd0 + 4);
#pragma unroll
            for (int e = 0; e < 4; ++e) { lg[e] += a[r] * w0[e]; lg[4 + e] += a[r] * w1[e]; } }
#pragma unroll
        for (int e = 0; e < 8; ++e) la[e] = (fminf(lg[e], 0.f) - __logf(1.f + __expf(-fabsf(lg[e])))) * 0.0625f;
    } else {
#pragma unroll
        for (int e = 0; e < 8; ++e) la[e] = 0.f;
    }
    *(LAS f32x4*)(LA + t * 64 + kd0) = (f32x4){la[0], la[1], la[2], la[3]}; *(LAS f32x4*)(LA + t * 64 + kd0 + 4) = (f32x4){la[4], la[5], la[6], la[7]};
    __syncthreads();
    if (tid < 64) { float run = 0.f;
#pragma unroll 16
        for (int tt = 0; tt < 64; ++tt) { run += LA[tt * 64 + tid]; LA[tt * 64 + tid] = run; } }
    __syncthreads();
    {
        float q[8], k[8], qd[8], kd[8]; UNPACK8(qv, q); UNPACK8(kv, k);
        const f32x4 b0 = *(const LAS f32x4*)(LA + t * 64 + kd0), b1 = *(const LAS f32x4*)(LA + t * 64 + kd0 + 4);
        const f32x4 l0 = *(const LAS f32x4*)(LA + 63 * 64 + kd0), l1 = *(const LAS f32x4*)(LA + 63 * 64 + kd0 + 4);
        const float b[8] = {b0[0], b0[1], b0[2], b0[3], b1[0], b1[1], b1[2], b1[3]}, bl[8] = {l0[0], l0[1], l0[2], l0[3], l1[0], l1[1], l1[2], l1[3]};
#pragma unroll
        for (int e = 0; e < 8; ++e) { qd[e] = q[e] * 0.125f * __expf(b[e]); kd[e] = k[e] * __expf(-b[e]);
            KT[(kd0 + e) * 72 + t] = act ? (bf16)f2bf(k[e] * __expf(bl[e] - b[e])) : (bf16)0; }
        if (act) { const size_t row = (size_t)(row0 + t);
            *(v4u*)((bf16*)(ws + WS_QD) + row * 256 + h * 64 + kd0) = PACK8(qd); *(v4u*)((bf16*)(ws + WS_KDEC) + row * 256 + h * 64 + kd0) = PACK8(kd); }
        const unsigned vw[8] = {vv0.x, vv0.y, vv0.z, vv0.w, vv1.x, vv1.y, vv1.z, vv1.w};
#pragma unroll
        for (int e = 0; e < 8; ++e) { VT[(v0 + 2 * e) * 72 + t] = (bf16)(vw[e] & 0xffffu); VT[(v0 + 2 * e + 1) * 72 + t] = (bf16)(vw[e] >> 16); }
        if (tid < 64) ((float*)(ws + WS_TAB + TAB_GD))[item * 64 + tid] = __expf(LA[63 * 64 + tid]);
    }
    __syncthreads();
    {
        const int fr = lane & 15, fq = lane >> 4;
        f32x4 acc[4];
#pragma unroll
        for (int j = 0; j < 4; ++j) acc[j] = zacc();
#pragma unroll
        for (int s = 0; s < 2; ++s) { const bf16x8 a = *(const LAS bf16x8*)(VT + (16 * wave + fr) * 72 + 32 * s + 8 * fq);
#pragma unroll
            for (int j = 0; j < 4; ++j) { const bf16x8 b = *(const LAS bf16x8*)(KT + (16 * j + fr) * 72 + 32 * s + 8 * fq); acc[j] = MFMA16(a, b, acc[j]); } }
        float* ut = (float*)(ws + WS_UT) + (size_t)item * 8192;
        __builtin_amdgcn_sched_barrier(0); asm volatile("s_nop 15\n\ts_nop 15" ::: "memory"); __builtin_amdgcn_sched_barrier(0);
#pragma unroll
        for (int j = 0; j < 4; ++j)
#pragma unroll
            for (int r = 0; r < 4; ++r) ut[(16 * wave + 4 * fq + r) * 64 + 16 * j + fr] = acc[j][r];
    }
    __syncthreads();
}
__device__ __forceinline__ void gla_passB(const Params& P, int item, LAS unsigned char* lds, int tid, int lane, int wave) {
    unsigned char* ws = P.ws;
    const bf16* PROJ = (const bf16*)(ws + WS_PROJ);
    int h, row0, T; gla_decode(item, h, row0, T);
    LAS bf16* QDL = (LAS bf16*)lds; LAS bf16* KDL = (LAS bf16*)(lds + 9216); LAS bf16* VT = (LAS bf16*)(lds + 18432); LAS bf16* ATT = (LAS bf16*)(lds + 36864); LAS float* SS = (LAS float*)(lds + 46080);
    const int t = tid >> 3, kg = tid & 7, kd0 = kg * 8, v0 = kg * 16;
    const bool act = t < T;
    {
        v4u qv = {0, 0, 0, 0}, kv = {0, 0, 0, 0}, vv0 = {0, 0, 0, 0}, vv1 = {0, 0, 0, 0};
        if (act) { const size_t row = (size_t)(row0 + t);
            qv = *(const v4u*)((const bf16*)(ws + WS_QD) + row * 256 + h * 64 + kd0); kv = *(const v4u*)((const bf16*)(ws + WS_KDEC) + row * 256 + h * 64 + kd0);
            vv0 = *(const v4u*)(PROJ + row * LDP + 1536 + h * 128 + v0); vv1 = *(const v4u*)(PROJ + row * LDP + 1536 + h * 128 + v0 + 8); }
        *(LAS v4u*)(QDL + t * 72 + kd0) = qv; *(LAS v4u*)(KDL + t * 72 + kd0) = kv;
        const unsigned vw[8] = {vv0.x, vv0.y, vv0.z, vv0.w, vv1.x, vv1.y, vv1.z, vv1.w};
#pragma unroll
        for (int e = 0; e < 8; ++e) { VT[(v0 + 2 * e) * 72 + t] = (bf16)(vw[e] & 0xffffu); VT[(v0 + 2 * e + 1) * 72 + t] = (bf16)(vw[e] >> 16); }
    }
    __syncthreads();
    const int fr = lane & 15, fq = lane >> 4;
    {
        const int i = wave >> 1;
#pragma unroll
        for (int jj = 0; jj < 2; ++jj) { const int j = 2 * (wave & 1) + jj;
            f32x4 acc = zacc();
            if (j <= i) {
#pragma unroll
                for (int s = 0; s < 2; ++s) { const bf16x8 a = *(const LAS bf16x8*)(QDL + (16 * i + fr) * 72 + 32 * s + 8 * fq), b = *(const LAS bf16x8*)(KDL + (16 * j + fr) * 72 + 32 * s + 8 * fq); acc = MFMA16(a, b, acc); }
            }
#pragma unroll
            for (int r = 0; r < 4; ++r) { const int rr = 16 * i + 4 * fq + r, cc = 16 * j + fr; const bool keep = (j < i) || (j == i && cc <= rr);
                ATT[rr * 72 + cc] = keep ? (bf16)f2bf(acc[r]) : (bf16)0; } }
    }
    __syncthreads();
    f32x4 acc[4];
#pragma unroll
    for (int i = 0; i < 4; ++i) acc[i] = zacc();
    {
        const bf16* st = (const bf16*)(ws + WS_ST) + (size_t)item * 8192 + (size_t)(16 * wave + fr) * 64 + 8 * fq;
#pragma unroll
        for (int s = 0; s < 2; ++s) { const bf16x8 bV = *(const LAS bf16x8*)(VT + (16 * wave + fr) * 72 + 32 * s + 8 * fq); const bf16x8 bS = *(const bf16x8*)(st + 32 * s);
#pragma unroll
            for (int i = 0; i < 4; ++i) { const bf16x8 aA = *(const LAS bf16x8*)(ATT + (16 * i + fr) * 72 + 32 * s + 8 * fq), aQ = *(const LAS bf16x8*)(QDL + (16 * i + fr) * 72 + 32 * s + 8 * fq);
                acc[i] = MFMA16(aA, bV, acc[i]); acc[i] = MFMA16(aQ, bS, acc[i]); } }
    }
#pragma unroll
    for (int i = 0; i < 4; ++i)
#pragma unroll
        for (int r = 0; r < 4; ++r) { float sq = acc[i][r] * acc[i][r]; sq += __shfl_xor(sq, 1); sq += __shfl_xor(sq, 2); sq += __shfl_xor(sq, 4); sq += __shfl_xor(sq, 8);
            if (fr == 0) SS[wave * 64 + 16 * i + 4 * fq + r] = sq; }
    __syncthreads();
    {
        const float gn = INP(21)[16 * wave + fr];
        bf16* MIX = (bf16*)(ws + WS_MIX);
#pragma unroll
        for (int i = 0; i < 4; ++i)
#pragma unroll
            for (int r = 0; r < 4; ++r) { const int tt = 16 * i + 4 * fq + r;
                if (tt < T) { float tot = 0.f;
#pragma unroll
                    for (int w = 0; w < 8; ++w) tot += SS[w * 64 + tt];
                    const float rs = 1.f / sqrtf(tot * (1.f / 128.f) + EPS);
                    const size_t row = (size_t)(row0 + tt); const int col = h * 128 + 16 * wave + fr;
                    const float gb = bf2f(PROJ[row * LDP + 2048 + col]);
                    MIX[row * 1024 + 512 + col] = (bf16)f2bf(acc[i][r] * rs * gn * silu(gb)); } }
    }
    __syncthreads();
}

__device__ __forceinline__ void phase3(const Params& P, LAS unsigned char* lds, int tid) {
    unsigned char* ws = P.ws; const int G = gridDim.x;
    const float* GD = (const float*)(ws + WS_TAB + TAB_GD);
    for (int b = blockIdx.x; b < 136; b += G) {
        if (b < 8) {
            const int i = b * 512 + tid, n = i >> 11, gp = i & 2047;
            const float2 lt = ((const float2*)(ws + WS_TAB + TAB_LAMT))[gp];
            const float2* loc = (const float2*)(ws + WS_LOC) + (size_t)n * 128 * 2048 + gp; float2* xin = (float2*)(ws + WS_XIN) + (size_t)n * 128 * 2048 + gp;
            float xr = 0.f, xi = 0.f;
#pragma unroll 16
            for (int c = 0; c < 128; ++c) { float2 l = loc[(size_t)c * 2048];  xin[(size_t)c * 2048] = make_float2(xr, xi);
                const float nr = lt.x * xr - lt.y * xi + l.x, ni = lt.x * xi + lt.y * xr + l.y; xr = nr; xi = ni; }
        } else {
            const int i = (b - 8) * 512 + tid, kd = i & 63, v = (i >> 6) & 127, h = (i >> 13) & 3, n = i >> 15;
            float S = 0.f;
#pragma unroll 16
            for (int c = 0; c < 128; ++c) { const int item = (n * 128 + c) * 4 + h; const size_t off = (size_t)item * 8192 + v * 64 + kd;
                const float uu = ((const float*)(ws + WS_UT))[off], d = GD[item * 64 + kd];
                ((bf16*)(ws + WS_ST))[off] = (bf16)f2bf(S); S = d * S + uu; }
            P.out[OFF_GLA_P + ((n * 4 + h) * 64 + kd) * 128 + v] = S;
        }
    }
    LAS float* tile = (LAS float*)lds;
    for (int j = blockIdx.x; j < 512; j += G) {
        const int item = 1024 + j; const size_t base = (size_t)j * 8192;
#pragma unroll
        for (int i = 0; i < 16; ++i) { const int e = tid + 512 * i; tile[(e >> 7) * 129 + (e & 127)] = INP(4)[base + e]; }
        __syncthreads();
#pragma unroll
        for (int i = 0; i < 16; ++i) { const int e = tid + 512 * i, v = e >> 6, kd = e & 63; const float sin_ = tile[kd * 129 + v];
            const size_t off = (size_t)item * 8192 + e;
            ((bf16*)(ws + WS_ST))[off] = (bf16)f2bf(sin_);
            tile[kd * 129 + v] = GD[item * 64 + kd] * sin_ + ((const float*)(ws + WS_UT))[off]; }
        __syncthreads();
#pragma unroll
        for (int i = 0; i < 16; ++i) { const int e = tid + 512 * i; P.out[OFF_GLA_S + base + e] = tile[(e >> 7) * 129 + (e & 127)]; }
        __syncthreads();
    }
}

__device__ __forceinline__ void attn_prompt(const Params& P, int item, LAS unsigned char* lds, int tid, int lane, int wave) {
    unsigned char* ws = P.ws;
    const bf16* Q = (const bf16*)(ws + WS_Q); const bf16* KV = (const bf16*)(ws + WS_KV); const bf16* GT = (const bf16*)(ws + WS_GATE); bf16* AO = (bf16*)(ws + WS_XN);
    const int qb = item & 63, kvh = (item >> 6) & 1, n = item >> 7;
    LAS bf16* KL = (LAS bf16*)lds; LAS bf16* VTL = (LAS bf16*)(lds + 36864); LAS bf16* PW = (LAS bf16*)(lds + 72704 + wave * 5440);
    LAS float* OS = (LAS float*)PW;
    const int head = kvh * 8 + wave, fr = lane & 15, fq = lane >> 4;
    const bf16* qbase = Q + (size_t)(n * 8192 + qb * 128 + fr) * 1024 + head * 64 + 8 * fq;
    bf16x8 aqc[2], aqn[2];
#pragma unroll
    for (int s = 0; s < 2; ++s) aqc[s] = *(const bf16x8*)(qbase + 32 * s);
    const int kr0 = n * 8192 + (qb - 1) * 128;
#pragma unroll
    for (int i = 0; i < 4; ++i) { const int c = tid + 512 * i;
        { const int key = c >> 3, part = c & 7; v4u kk = {0, 0, 0, 0}; if (qb > 0 || key >= 128) kk = *(const v4u*)(KV + (size_t)(kr0 + key) * 256 + kvh * 64 + part * 8); *(LAS v4u*)(KL + key * 72 + part * 8) = kk; }
        { const int key = c & 255, part = c >> 8; v4u vv = {0, 0, 0, 0}; if (qb > 0 || key >= 128) vv = *(const v4u*)(KV + (size_t)(kr0 + key) * 256 + 128 + kvh * 64 + part * 8);
            const unsigned vw[4] = {vv.x, vv.y, vv.z, vv.w};
#pragma unroll
            for (int e = 0; e < 4; ++e) { VTL[(part * 8 + 2 * e) * 280 + key] = (bf16)(vw[e] & 0xffffu); VTL[(part * 8 + 2 * e + 1) * 280 + key] = (bf16)(vw[e] >> 16); } } }
    for (int e = tid; e < 1024; e += 512) VTL[(e >> 4) * 280 + 256 + (e & 15)] = (bf16)0;
    __syncthreads();
    const float sink = INP(27)[head] * 1.4426950408889634f;
    for (int sb = 0; sb < 8; ++sb) {
        const int orow = lane >> 2, oseg = lane & 3;
        const size_t grow = (size_t)(n * 8192 + qb * 128 + 16 * sb + orow) * 1024 + head * 64 + 16 * oseg;
        const v4u g0 = *(const v4u*)(GT + grow), g1 = *(const v4u*)(GT + grow + 8);
        { const int sbn = sb < 7 ? sb + 1 : 7;
#pragma unroll
          for (int s = 0; s < 2; ++s) aqn[s] = *(const bf16x8*)(qbase + (size_t)(16 * sbn) * 1024 + 32 * s); }
        f32x4 sc[9];
#pragma unroll
        for (int kt = 0; kt < 9; ++kt) { sc[kt] = zacc();
#pragma unroll
            for (int s = 0; s < 2; ++s) { const bf16x8 b = *(const LAS bf16x8*)(KL + (16 * (sb + kt) + fr) * 72 + 32 * s + 8 * fq); sc[kt] = MFMA16(aqc[s], b, sc[kt]); } }
        aqc[0] = aqn[0]; aqc[1] = aqn[1];
        for (int e = lane; e < 384; e += 64) PW[(e / 24) * 168 + 144 + (e % 24)] = (bf16)0;
        float mx[4], sum[4];
#pragma unroll
        for (int r = 0; r < 4; ++r) { const int qi = 16 * sb + 4 * fq + r; float m = -3.0e38f;
#pragma unroll
            for (int kt = 0; kt < 9; ++kt) { const int kj = 16 * (sb + kt) + fr;
                const bool ok = (kt == 0 ? (kj > qi) : (kt == 8 ? (kj <= qi + 128) : true)) && (qb > 0 || kj >= 128);
                sc[kt][r] = ok ? sc[kt][r] : -3.0e38f; m = fmaxf(m, sc[kt][r]); }
            m = fmaxf(m, __shfl_xor(m, 1)); m = fmaxf(m, __shfl_xor(m, 2)); m = fmaxf(m, __shfl_xor(m, 4)); m = fmaxf(m, __shfl_xor(m, 8));
            mx[r] = fmaxf(m, sink); }
#pragma unroll
        for (int r = 0; r < 4; ++r) { float sm = 0.f;
#pragma unroll
            for (int kt = 0; kt < 9; ++kt) { const float pv = __builtin_amdgcn_exp2f(sc[kt][r] - mx[r]); sm += pv; PW[(4 * fq + r) * 168 + 16 * kt + fr] = (bf16)f2bf(pv); }
            sm += __shfl_xor(sm, 1); sm += __shfl_xor(sm, 2); sm += __shfl_xor(sm, 4); sm += __shfl_xor(sm, 8);
            sum[r] = 1.f / (sm + __builtin_amdgcn_exp2f(sink - mx[r])); }
        LDS_WAIT();
        f32x4 oa[4];
#pragma unroll
        for (int dt = 0; dt < 4; ++dt) oa[dt] = zacc();
#pragma unroll
        for (int s = 0; s < 5; ++s) { const bf16x8 a = *(const LAS bf16x8*)(PW + fr * 168 + 32 * s + 8 * fq);
#pragma unroll
            for (int dt = 0; dt < 4; ++dt) { const bf16x8 b = *(const LAS bf16x8*)(VTL + (16 * dt + fr) * 280 + 16 * sb + 32 * s + 8 * fq); oa[dt] = MFMA16(a, b, oa[dt]); } }
        LDS_WAIT();
        __builtin_amdgcn_sched_barrier(0); asm volatile("s_nop 15\n\ts_nop 15" ::: "memory"); __builtin_amdgcn_sched_barrier(0);
#pragma unroll
        for (int r = 0; r < 4; ++r) {
#pragma unroll
            for (int dt = 0; dt < 4; ++dt) OS[(4 * fq + r) * 68 + 16 * dt + fr] = oa[dt][r];
            if (fr == 0) OS[16 * 68 + 4 * fq + r] = sum[r]; }
        LDS_WAIT();
        {
            const float inv = OS[16 * 68 + orow];
            float gg[16]; UNPACK8(g0, gg); { float* g8 = gg + 8; UNPACK8(g1, g8); }
            float ov[16];
#pragma unroll
            for (int q4 = 0; q4 < 4; ++q4) { const f32x4 x = *(const LAS f32x4*)(OS + orow * 68 + 16 * oseg + 4 * q4);
#pragma unroll
                for (int e = 0; e < 4; ++e) ov[4 * q4 + e] = x[e] * inv * silu(gg[4 * q4 + e]); }
            *(v4u*)(AO + grow) = PACK8(ov); { const float* o8 = ov + 8; *(v4u*)(AO + grow + 8) = PACK8(o8); }
        }
        LDS_WAIT();
    }
    __syncthreads();
}
__device__ __forceinline__ void attn_sample(const Params& P, int item, LAS unsigned char* lds, int tid, int lane, int wave) {
    unsigned char* ws = P.ws;
    const bf16* Q = (const bf16*)(ws + WS_Q); const bf16* KV = (const bf16*)(ws + WS_KV); const bf16* GT = (const bf16*)(ws + WS_GATE); bf16* AO = (bf16*)(ws + WS_XN);
    const int seq = item >> 1, kvh = item & 1, head = kvh * 8 + wave;
    LAS float* KS = (LAS float*)lds; LAS float* VS = (LAS float*)(lds + 34336); LAS float* QS = (LAS float*)(lds + 68144) + wave * 256; LAS float* PS = (LAS float*)(lds + 76336) + wave * 544;
    const size_t R0 = (size_t)(MP + seq * 4);
    const float* kc = INP(5) + ((size_t)(seq * 128) * 2 + kvh) * 64; const float* vc = INP(6) + ((size_t)(seq * 128) * 2 + kvh) * 64;
#pragma unroll
    for (int i = 0; i < 4; ++i) { const int c = tid + 512 * i, key = c >> 4, p4 = c & 15;
        const f32x4 kx = *(const f32x4*)(kc + (size_t)key * 128 + 4 * p4), vx = *(const f32x4*)(vc + (size_t)key * 128 + 4 * p4);
        KS[key * 65 + 4 * p4] = kx[0]; KS[key * 65 + 4 * p4 + 1] = kx[1]; KS[key * 65 + 4 * p4 + 2] = kx[2]; KS[key * 65 + 4 * p4 + 3] = kx[3];
        *(LAS f32x4*)(VS + key * 64 + 4 * p4) = vx; }
    if (tid < 256) { const int key = tid >> 6, d = tid & 63; KS[(128 + key) * 65 + d] = bf2f(KV[(R0 + key) * 256 + kvh * 64 + d]); VS[(128 + key) * 64 + d] = bf2f(KV[(R0 + key) * 256 + 128 + kvh * 64 + d]); }
#pragma unroll
    for (int t = 0; t < 4; ++t) QS[t * 64 + lane] = bf2f(Q[(R0 + t) * 1024 + head * 64 + lane]);
    const float gt[4] = {bf2f(GT[(R0 + 0) * 1024 + head * 64 + lane]), bf2f(GT[(R0 + 1) * 1024 + head * 64 + lane]), bf2f(GT[(R0 + 2) * 1024 + head * 64 + lane]), bf2f(GT[(R0 + 3) * 1024 + head * 64 + lane])};
    __syncthreads();
    const float sink = INP(27)[head] * 1.4426950408889634f;
    float s[3][4];
#pragma unroll
    for (int kk = 0; kk < 3; ++kk)
#pragma unroll
        for (int t = 0; t < 4; ++t) s[kk][t] = 0.f;
    const int k2 = (lane < 4) ? 128 + lane : 0;
#pragma unroll 4
    for (int d4 = 0; d4 < 16; ++d4) {
        f32x4 qx[4];
#pragma unroll
        for (int t = 0; t < 4; ++t) qx[t] = *(const LAS f32x4*)(QS + t * 64 + 4 * d4);
#pragma unroll
        for (int e = 0; e < 4; ++e) { const float ka = KS[lane * 65 + 4 * d4 + e], kb = KS[(lane + 64) * 65 + 4 * d4 + e], kc2 = KS[k2 * 65 + 4 * d4 + e];
#pragma unroll
            for (int t = 0; t < 4; ++t) { s[0][t] += ka * qx[t][e]; s[1][t] += kb * qx[t][e]; s[2][t] += kc2 * qx[t][e]; } }
    }
    float inv[4];
#pragma unroll
    for (int t = 0; t < 4; ++t) {
        bool ok[3]; ok[0] = lane > t; ok[1] = true; ok[2] = (lane < 4) && (lane <= t);
        float m = -3.0e38f;
#pragma unroll
        for (int kk = 0; kk < 3; ++kk) m = ok[kk] ? fmaxf(m, s[kk][t]) : m;
        m = fmaxf(wave_max(m), sink);
        float sm = 0.f;
#pragma unroll
        for (int kk = 0; kk < 3; ++kk) { const float pv = ok[kk] ? __builtin_amdgcn_exp2f(s[kk][t] - m) : 0.f; sm += pv; if (kk < 2 || lane < 4) PS[(lane + 64 * kk) * 4 + t] = pv; }
        sm = wave_sum(sm) + __builtin_amdgcn_exp2f(sink - m);
        inv[t] = 1.f / sm;
    }
    LDS_WAIT();
    float o[4] = {0.f, 0.f, 0.f, 0.f};
#pragma unroll 4
    for (int key = 0; key < 132; ++key) { const float vx = VS[key * 64 + lane]; const f32x4 pp = *(const LAS f32x4*)(PS + key * 4);
#pragma unroll
        for (int t = 0; t < 4; ++t) o[t] += pp[t] * vx; }
#pragma unroll
    for (int t = 0; t < 4; ++t) AO[(R0 + t) * 1024 + head * 64 + lane] = (bf16)f2bf(o[t] * inv[t] * silu(gt[t]));
    __syncthreads();
}

__device__ __forceinline__ int fresh_tid() { int t = threadIdx.x; asm volatile("" : "+v"(t)); return t; }
__device__ __forceinline__ unsigned char* fresh_ptr(unsigned char* p) { asm volatile("" : "+s"(p)); return p; }
#define FRESH_IDS const int tid = fresh_tid(), lane = tid & 63, wave = __builtin_amdgcn_readfirstlane(tid >> 6), G = gridDim.x, bid = blockIdx.x, gw = bid * 8 + wave, NGW = G * 8; \
    unsigned char* ws = fresh_ptr(P.ws); LAS unsigned char* lds = lds0(); (void)lane; (void)gw; (void)NGW; (void)ws; (void)lds; (void)G; (void)bid;
#define GSYNC() do { XcdBarrier xb_; xb_.bar = (unsigned*)(fresh_ptr(P.ws) + WS_BAR); xb_.x = xb_xcc_id(); xb_.st = (volatile LAS unsigned*)(lds0() + LDS_BYTES - 64); xcd_barrier(xb_); } while (0)
__global__ void __launch_bounds__(512, 2) hybrid_fwd(Params P) {
    typedef pg8::StaticOrder SO;
    {
        FRESH_IDS
        volatile LAS unsigned* bst = (volatile LAS unsigned*)(lds + LDS_BYTES - 64);
        if (tid == 0) { bst[0] = 0u; bst[1] = 0u; }
        if (tid < 29) ((LAS unsigned long long*)(lds + PTAB_OFF))[tid] = (unsigned long long)P.in[tid];
        __syncthreads();
        (void)xcd_barrier_post((unsigned*)(ws + WS_BAR), bst);
        if (P.out == nullptr) cg::this_grid().sync();
        phase0<0>(P, lds, tid, lane, wave, 0);
    }
    GSYNC();
    {
        FRESH_IDS
        pg8::Gemm g{(const pg8::bf16_t*)(ws + WS_XN), (const pg8::bf16_t*)(ws + WS_W1T), MT, 2816, 1024}; SO S; S.init(MT, 2816, G, bid);
        EpiProj E{(bf16*)(ws + WS_PROJ), (float*)(ws + WS_ALOW)};
        pg8::gemm_phase<EpiProj, SO, true, true>(lds, g, S, E);
    }
    GSYNC();
    {
        FRESH_IDS
        s5_loop<false>(P, 8192, gw, NGW, lane, lds + wave * 12800);
        __syncthreads();
        for (int it = bid; it < 1536; it += G) gla_passA(P, it, lds, tid, lane, wave);
    }
    GSYNC();
    { FRESH_IDS phase3(P, lds, tid); }
    GSYNC();
    {
        FRESH_IDS
        s5_loop<true>(P, 12288, gw, NGW, lane, lds + wave * 12800);
        __syncthreads();
        for (int it = bid; it < 1536; it += G) gla_passB(P, it, lds, tid, lane, wave);
    }
    GSYNC();
    {
        FRESH_IDS
        pg8::Gemm g{(const pg8::bf16_t*)(ws + WS_Z), (const pg8::bf16_t*)(ws + WS_WGT), MT, 512, 512}; SO S; S.init(MT, 512, G, bid);
        EpiGlu E{(const bf16*)(ws + WS_Z), (const bf16*)(ws + WS_PROJ), INP(18), (bf16*)(ws + WS_MIX)};
        constexpr int NGLU = (MT / 256) * 2;
        if (bid < NGLU || G <= NGLU) pg8::gemm_phase<EpiGlu, SO, true, true>(lds, g, S, E);
        if (G <= NGLU) { __syncthreads(); phase0<1>(P, lds, tid, lane, wave, 0); }
        else if (bid >= NGLU) phase0<1>(P, lds, tid, lane, wave, NGLU);
    }
    GSYNC();
    {
        FRESH_IDS
        pg8::Gemm g{(const pg8::bf16_t*)(ws + WS_MIX), (const pg8::bf16_t*)(ws + WS_W3T), MT, 1024, 1024}; SO S; S.init(MT, 1024, G, bid);
        EpiResNorm E{INP(0), INP(1), (float*)(ws + WS_PROJ), (bf16*)(ws + WS_XN), INP(23), (float*)(ws + WS_TAB + TAB_SS)};
        pg8::gemm_phase<EpiResNorm, SO, true, true>(lds, g, S, E);
    }
    GSYNC();
    {
        FRESH_IDS
        pg8::Gemm g{(const pg8::bf16_t*)(ws + WS_XN), (const pg8::bf16_t*)(ws + WS_W4T), MT, 2304, 1024}; SO S; S.init(MT, 2304, G, bid);
        EpiQKV E{(bf16*)(ws + WS_Q), (bf16*)(ws + WS_KV), (bf16*)(ws + WS_GATE), INP(25), INP(26), (const float2*)(ws + WS_ROPE), P.out, (const float*)(ws + WS_TAB + TAB_SS)};
        pg8::gemm_phase<EpiQKV, SO, true, true>(lds, g, S, E);
    }
    GSYNC();
    {
        FRESH_IDS
        for (int it = bid; it < 256; it += G) attn_prompt(P, it, lds, tid, lane, wave);
        for (int it = bid; it < 256; it += G) attn_sample(P, it, lds, tid, lane, wave);
    }
    GSYNC();
    {
        FRESH_IDS
        pg8::Gemm g{(const pg8::bf16_t*)(ws + WS_XN), (const pg8::bf16_t*)(ws + WS_W6T), MT, 1024, 1024}; SO S; S.init(MT, 1024, G, bid);
        const float* H1 = (const float*)(ws + WS_PROJ);
        EpiRes E{H1, H1 + (size_t)MP * 1024, P.out};
        pg8::gemm_phase<EpiRes, SO, true, true>(lds, g, S, E);
    }
}

extern "C" void kernel_launch(void* const* d_in, const int* in_sizes, int n_in, void* d_out, int out_size, void* d_ws, size_t ws_size, hipStream_t stream) {
    static int grid = 0;
    if (grid == 0) {
        if (n_in != 29 || out_size != OUT_TOTAL || ws_size < WS_END) { fprintf(stderr, "kernel_launch: unexpected shapes (n_in %d out %d ws %zu)\n", n_in, out_size, ws_size); grid = -1; return; }
        int dev = 0, cus = 0, per_cu = 0;
        hipGetDevice(&dev); hipDeviceGetAttribute(&cus, hipDeviceAttributeMultiprocessorCount, dev);
        if (hipFuncSetAttribute((const void*)hybrid_fwd, hipFuncAttributeMaxDynamicSharedMemorySize, LDS_BYTES) != hipSuccess) { fprintf(stderr, "kernel_launch: hipFuncSetAttribute failed\n"); grid = -1; return; }
        if (hipOccupancyMaxActiveBlocksPerMultiprocessor(&per_cu, (const void*)hybrid_fwd, 512, LDS_BYTES) != hipSuccess || per_cu < 1) { fprintf(stderr, "kernel_launch: occupancy query says %d\n", per_cu); per_cu = 1; }
        (void)hipGetLastError();
        grid = cus;
    }
    if (grid < 0) return;
    Params p{};
    for (int i = 0; i < 29; ++i) p.in[i] = (const float*)d_in[i];
    p.out = (float*)d_out; p.ws = (unsigned char*)d_ws;
    if (hipMemsetAsync((unsigned char*)d_ws + WS_BAR, 0, 16384, stream) != hipSuccess) { fprintf(stderr, "kernel_launch: memset of the barrier words failed\n"); return; }
    void* args[] = {&p};
    const hipError_t e = hipLaunchCooperativeKernel((const void*)hybrid_fwd, dim3(grid), dim3(512), args, LDS_BYTES, stream);
    if (e != hipSuccess) fprintf(stderr, "kernel_launch: cooperative launch failed: %s (grid %d)\n", hipGetErrorString(e), grid);
}
```
